# Optimizing an MI355X kernel written in HIP

```python
import jax, jax.numpy as jnp
from jax import lax
import numpy as np

D_MODEL = 1024
BATCH = 8
SEQ = 4096
DEPTH = 1

CHUNK = 64
N_LEFT_CHUNKS = 8
BAND = (N_LEFT_CHUNKS + 1) * CHUNK
ATT_HEADS = 8
HEAD_DIM = 64
D_ATT = ATT_HEADS * HEAD_DIM
REL_CLIP = 256
N_REL = 2 * REL_CLIP + 1
SGU_BLOCK = 128
SGU_GROUPS = 8
SGU_GROUP_DIM = 64
D_SGU = SGU_GROUPS * SGU_GROUP_DIM
D_FF = 2816
D_IN = 3 * D_ATT + 2 * D_SGU + 2 * D_MODEL
EPS = 1e-6
NEG_INF = -1e30

kernel_name = "macaron_gated_chunkattn_gmlp_block"


def rmsnorm(x, g):
    xf = x.astype(jnp.float32)
    y = xf * lax.rsqrt(jnp.mean(xf * xf, axis=-1, keepdims=True) + EPS)
    return (y * g.astype(jnp.float32)).astype(x.dtype)


def layernorm(x, g, b):
    xf = x.astype(jnp.float32)
    mu = jnp.mean(xf, axis=-1, keepdims=True)
    var = jnp.mean(jnp.square(xf - mu), axis=-1, keepdims=True)
    y = (xf - mu) * lax.rsqrt(var + EPS)
    return (y * g.astype(jnp.float32) + b.astype(jnp.float32)).astype(x.dtype)


def swiglu(h, w_gate, w_up, w_down):
    return (jax.nn.silu(h @ w_gate) * (h @ w_up)) @ w_down


def chunked_rel_attention(q, k, v, rel_table):
    B, S = q.shape[0], q.shape[1]
    n_c = S // CHUNK
    pad = N_LEFT_CHUNKS * CHUNK
    qc = q.reshape(B, n_c, CHUNK, ATT_HEADS, HEAD_DIM)
    kp = jnp.pad(k, ((0, 0), (pad, 0), (0, 0), (0, 0))).reshape(B, n_c + N_LEFT_CHUNKS, CHUNK, ATT_HEADS, HEAD_DIM)
    vp = jnp.pad(v, ((0, 0), (pad, 0), (0, 0), (0, 0))).reshape(B, n_c + N_LEFT_CHUNKS, CHUNK, ATT_HEADS, HEAD_DIM)
    k_band = jnp.concatenate([kp[:, i:i + n_c] for i in range(N_LEFT_CHUNKS + 1)], axis=2)
    v_band = jnp.concatenate([vp[:, i:i + n_c] for i in range(N_LEFT_CHUNKS + 1)], axis=2)
    scores = jnp.einsum('bcqhd,bckhd->bchqk', qc, k_band).astype(jnp.float32) * (HEAD_DIM ** -0.5)
    qi = jnp.arange(CHUNK)[:, None]
    kj = jnp.arange(BAND)[None, :]
    rel = jnp.clip(qi + pad - kj, -REL_CLIP, REL_CLIP) + REL_CLIP
    bias = rel_table.astype(jnp.float32)[:, rel]
    key_pos = jnp.arange(n_c)[:, None] * CHUNK + jnp.arange(BAND)[None, :] - pad
    valid = key_pos >= 0
    scores = jnp.where(valid[None, :, None, None, :], scores + bias[None, None], NEG_INF)
    probs = jax.nn.softmax(scores, axis=-1).astype(v.dtype)
    out = jnp.einsum('bchqk,bckhd->bcqhd', probs, v_band)
    return out.reshape(B, S, D_ATT)


def spatial_gating(z, ln_g, ln_b, w_s, b_s):
    B, S = z.shape[0], z.shape[1]
    n_blk = S // SGU_BLOCK
    u, vs = z[..., :D_SGU], z[..., D_SGU:]
    vs = layernorm(vs, ln_g, ln_b).reshape(B, n_blk, SGU_BLOCK, SGU_GROUPS, SGU_GROUP_DIM)
    pos = jnp.arange(SGU_BLOCK)
    mask = (pos[:, None] // CHUNK) >= (pos[None, :] // CHUNK)
    w_m = jnp.where(mask[None], w_s, jnp.zeros_like(w_s))
    s = jnp.einsum('gij,bnjgd->bnigd', w_m, vs) + b_s.T[None, None, :, :, None]
    return u * s.reshape(B, S, D_SGU)


def setup_inputs(seed: int = 0) -> dict:
    key = jax.random.key(seed)
    ks = jax.random.split(key, 24)
    L = DEPTH
    f32 = jnp.float32

    def nrm(k, shape, scale):
        return jax.random.normal(k, shape, f32) * scale

    def gain(k, shape):
        return 1.0 + 0.05 * jax.random.normal(k, shape, f32)

    return {
        "x": jax.random.normal(ks[0], (BATCH, SEQ, D_MODEL), f32),
        "norm_ffn1": gain(ks[1], (L, D_MODEL)),
        "ffn1_w_gate": nrm(ks[2], (L, D_MODEL, D_FF), D_MODEL ** -0.5),
        "ffn1_w_up": nrm(ks[3], (L, D_MODEL, D_FF), D_MODEL ** -0.5),
        "ffn1_w_down": nrm(ks[4], (L, D_FF, D_MODEL), D_FF ** -0.5),
        "norm_mix": gain(ks[5], (L, D_MODEL)),
        "w_in": nrm(ks[6], (L, D_MODEL, D_IN), D_MODEL ** -0.5),
        "b_gate": nrm(ks[7], (L, 2 * D_MODEL), 0.01),
        "rel_bias": nrm(ks[8], (L, ATT_HEADS, N_REL), 0.1),
        "sgu_ln_g": gain(ks[9], (L, D_SGU)),
        "sgu_ln_b": nrm(ks[10], (L, D_SGU), 0.01),
        "sgu_w_s": nrm(ks[11], (L, SGU_GROUPS, SGU_BLOCK, SGU_BLOCK), SGU_BLOCK ** -0.5),
        "sgu_b_s": gain(ks[12], (L, SGU_GROUPS, SGU_BLOCK)),
        "w_branch_att": nrm(ks[13], (L, D_ATT, D_MODEL), D_ATT ** -0.5),
        "w_branch_sgu": nrm(ks[14], (L, D_SGU, D_MODEL), D_SGU ** -0.5),
        "w_out": nrm(ks[15], (L, D_MODEL, D_MODEL), D_MODEL ** -0.5),
        "norm_ffn2": gain(ks[16], (L, D_MODEL)),
        "ffn2_w_gate": nrm(ks[17], (L, D_MODEL, D_FF), D_MODEL ** -0.5),
        "ffn2_w_up": nrm(ks[18], (L, D_MODEL, D_FF), D_MODEL ** -0.5),
        "ffn2_w_down": nrm(ks[19], (L, D_FF, D_MODEL), D_FF ** -0.5),
        "norm_final": gain(ks[20], (D_MODEL,)),
    }


def reference(x, norm_ffn1, ffn1_w_gate, ffn1_w_up, ffn1_w_down, norm_mix, w_in, b_gate,
              rel_bias, sgu_ln_g, sgu_ln_b, sgu_w_s, sgu_b_s, w_branch_att, w_branch_sgu,
              w_out, norm_ffn2, ffn2_w_gate, ffn2_w_up, ffn2_w_down, norm_final):
    B, S = x.shape[0], x.shape[1]
    for l in range(DEPTH):
        x = x + 0.5 * swiglu(rmsnorm(x, norm_ffn1[l]), ffn1_w_gate[l], ffn1_w_up[l], ffn1_w_down[l])
        h = rmsnorm(x, norm_mix[l])
        z = h @ w_in[l]
        o = 0
        q = z[..., o:o + D_ATT].reshape(B, S, ATT_HEADS, HEAD_DIM); o += D_ATT
        k = z[..., o:o + D_ATT].reshape(B, S, ATT_HEADS, HEAD_DIM); o += D_ATT
        v = z[..., o:o + D_ATT].reshape(B, S, ATT_HEADS, HEAD_DIM); o += D_ATT
        z_sgu = jax.nn.gelu(z[..., o:o + 2 * D_SGU]); o += 2 * D_SGU
        g = jax.nn.sigmoid(z[..., o:o + 2 * D_MODEL] + b_gate[l])
        g_att, g_sgu = g[..., :D_MODEL], g[..., D_MODEL:]
        y_att = chunked_rel_attention(q, k, v, rel_bias[l])
        y_sgu = spatial_gating(z_sgu, sgu_ln_g[l], sgu_ln_b[l], sgu_w_s[l], sgu_b_s[l])
        merged = g_att * (y_att @ w_branch_att[l]) + g_sgu * (y_sgu @ w_branch_sgu[l])
        x = x + merged @ w_out[l]
        x = x + 0.5 * swiglu(rmsnorm(x, norm_ffn2[l]), ffn2_w_gate[l], ffn2_w_up[l], ffn2_w_down[l])
    return rmsnorm(x, norm_final)
```

```cpp
#include <hip/hip_runtime.h>
#include <hip/hip_cooperative_groups.h>
#include <cstdio>
#include <cstdint>
namespace pg8 {
#define PG8_LAS __attribute__((address_space(3)))
typedef unsigned short bf16_t;
typedef short bf16x8 __attribute__((ext_vector_type(8)));
typedef float f32x4 __attribute__((ext_vector_type(4)));
typedef unsigned u32x4 __attribute__((ext_vector_type(4)));
constexpr int BM = 256, BK = 64, HALF = 128, HTB = HALF * BK * 2  , STAGE_BYTES = 8 * HTB, NXCD = 8, WGM = 8;

__host__ __device__ __forceinline__ int lds_byte(int r, int c) { const int st = (r >> 4) * 2 + (c >> 5), rr = r & 15, cc = c & 31, ob = rr * 64 + cc * 2; return st * 1024 + (ob ^ (((ob >> 9) & 1) << 5)); }
__host__ __device__ __forceinline__ void stage_rc(int b, int& R, int& C) { const int st = b / 1024, sb = b % 1024, swz = sb ^ (((sb >> 9) & 1) << 5); R = (st >> 1) * 16 + swz / 64; C = (st & 1) * 32 + (swz % 64) / 2; }
__host__ __device__ __forceinline__ int perm32(int rho) { const int n = rho >> 4, i = rho & 15; return 8 * (i >> 2) + 4 * n + (i & 3); }

struct Unit { int pm, pn; };
struct Gemm { const bf16_t* A; const bf16_t* Bt; int M, N, K; };

struct StaticOrder {
    int nM, nN, nwg, G, c, wgm;
    __host__ __device__ void init(int M, int N, int G_, int c_, int wgm_ = WGM) { nM = M / BM; nN = N / BM; nwg = nM * nN; G = G_; c = c_; wgm = wgm_; }
    __host__ __device__ bool next(int i, Unit& u) const {
        const long L = (long)i * G + c; if (L >= nwg) return false;
        int wgid = (int)L; { const int q = nwg / NXCD, r = nwg % NXCD, xcd = wgid % NXCD, off = wgid / NXCD; wgid = (xcd < r ? xcd * (q + 1) : r * (q + 1) + (xcd - r) * q) + off; }
        const int nig = wgm * nN, gid = wgid / nig, fm = gid * wgm, gsz = (nM - fm) < wgm ? (nM - fm) : wgm;
        u.pm = fm + ((wgid % nig) % gsz); u.pn = (wgid % nig) / gsz; return true;
    }
    __device__ __forceinline__ void a_ready(const Unit&) const {}
    __device__ __forceinline__ void done(const Unit&) const {}
};


typedef float f32x2_t __attribute__((ext_vector_type(2))); typedef __bf16 bf16x2_t __attribute__((ext_vector_type(2)));
__device__ __forceinline__ unsigned cvt_pk_bf16(float lo, float hi) { f32x2_t v = {lo, hi}; bf16x2_t b = __builtin_convertvector(v, bf16x2_t); return __builtin_bit_cast(unsigned, b); }
__device__ __forceinline__ float bf_lo(unsigned w) { return __uint_as_float(w << 16); }
__device__ __forceinline__ float bf_hi(unsigned w) { return __uint_as_float(w & 0xffff0000u); }
__device__ __forceinline__ void st16_wt(void* p, u32x4 v) { __builtin_nontemporal_store(v, (u32x4*)p); }
__device__ __forceinline__ void st16_wt(void* p, f32x4 v) { __builtin_nontemporal_store(v, (f32x4*)p); }
constexpr float LOG2E = 1.4426950408889634f;
__device__ __forceinline__ float fsigmoid(float x) { return __builtin_amdgcn_rcpf(1.0f + __builtin_amdgcn_exp2f(-LOG2E * x)); }
__device__ __forceinline__ float row_rstd(const float* ss, int row) {
    const f32x4* p = (const f32x4*)(ss + (size_t)row * 16);
    const f32x4 a = p[0], b = p[1], c = p[2], d = p[3];
    const float s = ((a[0] + a[1]) + (a[2] + a[3])) + ((b[0] + b[1]) + (b[2] + b[3])) + ((c[0] + c[1]) + (c[2] + c[3])) + ((d[0] + d[1]) + (d[2] + d[3]));
    return __builtin_amdgcn_rsqf(s * (1.0f / 1024.0f) + 1e-6f);
}

__device__ __forceinline__ void rows_rstd(float (&rs)[2][4], const float* ss, int row0, int fq) {
    f32x4 p[2][4];
#pragma unroll
    for (int ai = 0; ai < 2; ++ai)
#pragma unroll
        for (int m = 0; m < 4; ++m) p[ai][m] = *(const f32x4*)(ss + (size_t)(row0 + ai * HALF + m * 16) * 16 + 4 * fq);
#pragma unroll
    for (int ai = 0; ai < 2; ++ai)
#pragma unroll
        for (int m = 0; m < 4; ++m) { float s = (p[ai][m][0] + p[ai][m][1]) + (p[ai][m][2] + p[ai][m][3]); s += __shfl_xor(s, 16); s += __shfl_xor(s, 32); rs[ai][m] = __builtin_amdgcn_rsqf(s * (1.0f / 1024.0f) + 1e-6f); }
}

struct EpiSwiglu {
    static constexpr bool PERM = true, AFTER_DRAIN = false, HAS_INIT = false, HAS_MID = false;
    bf16_t* O; int ldc; const float* ss;
    __device__ __forceinline__ void operator()(const f32x4 (&acc)[2][2][4][2], const Unit& u, int wr, int wc, int fr, int fq) const {
        const int row0 = u.pm * BM + wr * 64 + fr; const int col0 = u.pn * HALF + wc * 32 + 8 * fq;
        float rsv[2][4]; rows_rstd(rsv, ss, row0, fq);
#pragma unroll
        for (int ai = 0; ai < 2; ++ai)
#pragma unroll
            for (int m = 0; m < 4; ++m) {
                const int row = row0 + ai * HALF + m * 16; const float rs = rsv[ai][m];
                float o[8];
#pragma unroll
                for (int n = 0; n < 2; ++n)
#pragma unroll
                    for (int i = 0; i < 4; ++i) { const float g = acc[ai][0][m][n][i] * rs, up = acc[ai][1][m][n][i] * rs; o[4 * n + i] = g * fsigmoid(g) * up; }
                u32x4 w; w.x = cvt_pk_bf16(o[0], o[1]); w.y = cvt_pk_bf16(o[2], o[3]); w.z = cvt_pk_bf16(o[4], o[5]); w.w = cvt_pk_bf16(o[6], o[7]);
                st16_wt(O + (size_t)row * ldc + col0, w);
            }
    }
};

struct EpiResid {
    static constexpr bool PERM = true, AFTER_DRAIN = false, HAS_INIT = true, HAS_MID = false;
    const float* base; float* out; bf16_t* xb; float* ssout; float scale, inv_scale;
    __device__ __forceinline__ void init(f32x4 (&acc)[2][2][4][2], const Unit& u, int wr, int wc, int fr, int fq) const {
        const int row0 = u.pm * BM + wr * 64 + fr; const int col0 = u.pn * BM + wc * 32 + 8 * fq;
#pragma unroll
        for (int ai = 0; ai < 2; ++ai)
#pragma unroll
            for (int m = 0; m < 4; ++m) { const size_t off = (size_t)(row0 + ai * HALF + m * 16) * 1024 + col0;
#pragma unroll
                for (int bj = 0; bj < 2; ++bj)
#pragma unroll
                    for (int n = 0; n < 2; ++n) acc[ai][bj][m][n] = *(const f32x4*)(base + off + bj * HALF + n * 4) * inv_scale; }
    }
    __device__ __forceinline__ void operator()(const f32x4 (&acc)[2][2][4][2], const Unit& u, int wr, int wc, int fr, int fq) const {
        const int row0 = u.pm * BM + wr * 64 + fr; const int col0 = u.pn * BM + wc * 32 + 8 * fq;
#pragma unroll
        for (int ai = 0; ai < 2; ++ai)
#pragma unroll
            for (int m = 0; m < 4; ++m) {
                const int row = row0 + ai * HALF + m * 16; const size_t off = (size_t)row * 1024 + col0; float q = 0.f;
#pragma unroll
                for (int bj = 0; bj < 2; ++bj) {
                    const f32x4 v0 = acc[ai][bj][m][0] * scale, v1 = acc[ai][bj][m][1] * scale;
                    q += ((v0[0] * v0[0] + v0[1] * v0[1]) + (v0[2] * v0[2] + v0[3] * v0[3])) + ((v1[0] * v1[0] + v1[1] * v1[1]) + (v1[2] * v1[2] + v1[3] * v1[3]));
                    *(f32x4*)(out + off + bj * HALF) = v0; *(f32x4*)(out + off + bj * HALF + 4) = v1;
                    if (xb) { u32x4 w; w.x = cvt_pk_bf16(v0[0], v0[1]); w.y = cvt_pk_bf16(v0[2], v0[3]); w.z = cvt_pk_bf16(v1[0], v1[1]); w.w = cvt_pk_bf16(v1[2], v1[3]); st16_wt(xb + off + bj * HALF, w); }
                }
                q += __shfl_xor(q, 16); q += __shfl_xor(q, 32);
                if (fq == 0) ssout[(size_t)row * 16 + u.pn * 4 + wc] = q;
            }
    }
};

struct EpiResidNorm {
    static constexpr bool PERM = true, AFTER_DRAIN = false, HAS_INIT = true, HAS_MID = false;
    const float* base; float* out; float* ssx; unsigned* cnt; const float* gfin; float scale, inv_scale;
    __device__ __forceinline__ void init(f32x4 (&acc)[2][2][4][2], const Unit& u, int wr, int wc, int fr, int fq) const {
        const int row0 = u.pm * BM + wr * 64 + fr; const int col0 = u.pn * BM + wc * 32 + 8 * fq;
#pragma unroll
        for (int ai = 0; ai < 2; ++ai)
#pragma unroll
            for (int m = 0; m < 4; ++m) { const size_t off = (size_t)(row0 + ai * HALF + m * 16) * 1024 + col0;
#pragma unroll
                for (int bj = 0; bj < 2; ++bj)
#pragma unroll
                    for (int n = 0; n < 2; ++n) acc[ai][bj][m][n] = *(const f32x4*)(base + off + bj * HALF + n * 4) * inv_scale; }
    }
    __device__ __forceinline__ void operator()(f32x4 (&acc)[2][2][4][2], const Unit& u, int wr, int wc, int fr, int fq) const {
        const int row0 = u.pm * BM + wr * 64 + fr; const int col0 = u.pn * BM + wc * 32 + 8 * fq;
#pragma unroll
        for (int ai = 0; ai < 2; ++ai)
#pragma unroll
            for (int m = 0; m < 4; ++m) { float q = 0.f;
#pragma unroll
                for (int bj = 0; bj < 2; ++bj)
#pragma unroll
                    for (int n = 0; n < 2; ++n) { const f32x4 v = acc[ai][bj][m][n] * scale; acc[ai][bj][m][n] = v; q += (v[0] * v[0] + v[1] * v[1]) + (v[2] * v[2] + v[3] * v[3]); }
                q += __shfl_xor(q, 16); q += __shfl_xor(q, 32);
                if (fq == 0) __hip_atomic_store(ssx + (size_t)(row0 + ai * HALF + m * 16) * 16 + u.pn * 4 + wc, q, __ATOMIC_RELAXED, __HIP_MEMORY_SCOPE_AGENT); }
        asm volatile("s_waitcnt vmcnt(0)" ::: "memory");
        unsigned* c = cnt + 64 * u.pm;
        if (fr == 0 && fq == 0) __hip_atomic_fetch_add(c, 1u, __ATOMIC_RELAXED, __HIP_MEMORY_SCOPE_AGENT);
        { unsigned sp = 0; while (__hip_atomic_load(c, __ATOMIC_RELAXED, __HIP_MEMORY_SCOPE_AGENT) < 32u) { __builtin_amdgcn_s_sleep(1); if (++sp > (1u << 20)) break; } }
        asm volatile("" ::: "memory");
        f32x4 gf[2][2];
#pragma unroll
        for (int bj = 0; bj < 2; ++bj)
#pragma unroll
            for (int n = 0; n < 2; ++n) gf[bj][n] = *(const f32x4*)(gfin + col0 + bj * HALF + n * 4);
        float rs[2][4];
#pragma unroll
        for (int ai = 0; ai < 2; ++ai)
#pragma unroll
            for (int m = 0; m < 4; ++m) { const float* p = ssx + (size_t)(row0 + ai * HALF + m * 16) * 16 + 4 * fq;
                float s = (__hip_atomic_load(p, __ATOMIC_RELAXED, __HIP_MEMORY_SCOPE_AGENT) + __hip_atomic_load(p + 1, __ATOMIC_RELAXED, __HIP_MEMORY_SCOPE_AGENT))
                        + (__hip_atomic_load(p + 2, __ATOMIC_RELAXED, __HIP_MEMORY_SCOPE_AGENT) + __hip_atomic_load(p + 3, __ATOMIC_RELAXED, __HIP_MEMORY_SCOPE_AGENT));
                rs[ai][m] = s; }
#pragma unroll
        for (int ai = 0; ai < 2; ++ai)
#pragma unroll
            for (int m = 0; m < 4; ++m) { float s = rs[ai][m]; s += __shfl_xor(s, 16); s += __shfl_xor(s, 32); const float r = __builtin_amdgcn_rsqf(s * (1.0f / 1024.0f) + 1e-6f);
                const size_t off = (size_t)(row0 + ai * HALF + m * 16) * 1024 + col0;
#pragma unroll
                for (int bj = 0; bj < 2; ++bj)
#pragma unroll
                    for (int n = 0; n < 2; ++n) *(f32x4*)(out + off + bj * HALF + n * 4) = acc[ai][bj][m][n] * r * gf[bj][n]; }
    }
};

constexpr float QSCALE = 0.125f * LOG2E;
struct EpiWin {
    static constexpr bool PERM = true, AFTER_DRAIN = false, HAS_INIT = false, HAS_MID = false;
    bf16_t* QKV; bf16_t* UV; bf16_t* GATES; const float* bgate; const float* ss;
    template <int MODE> __device__ __forceinline__ void run(const f32x4 (&acc)[2][2][4][2], bf16_t* O, int ldc, int cbase, int row0, int ct) const {
        f32x4 bv[2][2];
#pragma unroll
        for (int bj = 0; bj < 2; ++bj)
#pragma unroll
            for (int n = 0; n < 2; ++n) bv[bj][n] = (MODE == 3) ? *(const f32x4*)(bgate + cbase + bj * HALF + ct + 4 * n) : (f32x4){0.f, 0.f, 0.f, 0.f};
        float rsv[2][4]; rows_rstd(rsv, ss, row0, ct >> 3 & 3);
#pragma unroll
        for (int ai = 0; ai < 2; ++ai)
#pragma unroll
            for (int m = 0; m < 4; ++m) {
                const int row = row0 + ai * HALF + m * 16; const float rs = rsv[ai][m];
#pragma unroll
                for (int bj = 0; bj < 2; ++bj) {
                    float o[8];
#pragma unroll
                    for (int n = 0; n < 2; ++n)
#pragma unroll
                        for (int i = 0; i < 4; ++i) {
                            float z = acc[ai][bj][m][n][i] * rs;
                            if (MODE == 0) z *= QSCALE;
                            else if (MODE == 2) { const float t = 1.5957691216f * (z + 0.044715f * z * z * z); z = z * fsigmoid(t); }
                            else if (MODE == 3) z = fsigmoid(z + bv[bj][n][i]);
                            o[4 * n + i] = z;
                        }
                    u32x4 w; w.x = cvt_pk_bf16(o[0], o[1]); w.y = cvt_pk_bf16(o[2], o[3]); w.z = cvt_pk_bf16(o[4], o[5]); w.w = cvt_pk_bf16(o[6], o[7]);
                    st16_wt(O + (size_t)row * ldc + cbase + bj * HALF + ct, w);
                }
            }
    }
    __device__ __forceinline__ void operator()(const f32x4 (&acc)[2][2][4][2], const Unit& u, int wr, int wc, int fr, int fq) const {
        const int row0 = u.pm * BM + wr * 64 + fr; const int ct = wc * 32 + 8 * fq; const int pn = u.pn;
        if (pn < 2) run<0>(acc, QKV, 1536, pn * BM, row0, ct);
        else if (pn < 6) run<1>(acc, QKV, 1536, pn * BM, row0, ct);
        else if (pn < 10) run<2>(acc, UV, 1024, pn * BM - 1536, row0, ct);
        else run<3>(acc, GATES, 2048, pn * BM - 2560, row0, ct);
    }
};

struct EpiBranchCat {
    static constexpr bool PERM = true, AFTER_DRAIN = false, HAS_INIT = false, HAS_MID = true;
    bf16_t* MG; const bf16_t* G; int mid_t;
    __device__ __forceinline__ void mid(f32x4 (&acc)[2][2][4][2], const Unit& u, int wr, int wc, int fr, int fq) const {
        int row0 = u.pm * BM + wr * 64 + fr; int col0 = u.pn * BM + wc * 32 + 8 * fq;
        asm volatile("" : "+v"(row0), "+v"(col0));
#pragma unroll
        for (int ai = 0; ai < 2; ++ai)
#pragma unroll
          for (int mh = 0; mh < 2; ++mh) {
            u32x4 ga[2][2], gs[2][2];
#pragma unroll
            for (int mm = 0; mm < 2; ++mm)
#pragma unroll
                for (int bj = 0; bj < 2; ++bj) { const bf16_t* gp = G + (size_t)(row0 + ai * HALF + (2 * mh + mm) * 16) * 2048 + col0 + bj * HALF; ga[mm][bj] = *(const u32x4*)gp; gs[mm][bj] = *(const u32x4*)(gp + 1024); }
#pragma unroll
            for (int mm = 0; mm < 2; ++mm)
#pragma unroll
                for (int bj = 0; bj < 2; ++bj) { const u32x4 a = ga[mm][bj], s = gs[mm][bj]; const int m = 2 * mh + mm;
                    f32x4 r0, r1;
                    r0[0] = bf_lo(a.x) * __builtin_amdgcn_rcpf(fmaxf(bf_lo(s.x), 1e-20f)); r0[1] = bf_hi(a.x) * __builtin_amdgcn_rcpf(fmaxf(bf_hi(s.x), 1e-20f));
                    r0[2] = bf_lo(a.y) * __builtin_amdgcn_rcpf(fmaxf(bf_lo(s.y), 1e-20f)); r0[3] = bf_hi(a.y) * __builtin_amdgcn_rcpf(fmaxf(bf_hi(s.y), 1e-20f));
                    r1[0] = bf_lo(a.z) * __builtin_amdgcn_rcpf(fmaxf(bf_lo(s.z), 1e-20f)); r1[1] = bf_hi(a.z) * __builtin_amdgcn_rcpf(fmaxf(bf_hi(s.z), 1e-20f));
                    r1[2] = bf_lo(a.w) * __builtin_amdgcn_rcpf(fmaxf(bf_lo(s.w), 1e-20f)); r1[3] = bf_hi(a.w) * __builtin_amdgcn_rcpf(fmaxf(bf_hi(s.w), 1e-20f));
                    acc[ai][bj][m][0] *= r0; acc[ai][bj][m][1] *= r1; }
            asm volatile("" ::: "memory");
          }
    }
    __device__ __forceinline__ void operator()(const f32x4 (&acc)[2][2][4][2], const Unit& u, int wr, int wc, int fr, int fq) const {
        const int row0 = u.pm * BM + wr * 64 + fr; const int col0 = u.pn * BM + wc * 32 + 8 * fq;
#pragma unroll
        for (int ai = 0; ai < 2; ++ai) {
            u32x4 gs[4][2];
#pragma unroll
            for (int m = 0; m < 4; ++m)
#pragma unroll
                for (int bj = 0; bj < 2; ++bj) gs[m][bj] = *(const u32x4*)(G + (size_t)(row0 + ai * HALF + m * 16) * 2048 + 1024 + col0 + bj * HALF);
#pragma unroll
            for (int m = 0; m < 4; ++m)
#pragma unroll
                for (int bj = 0; bj < 2; ++bj) { const u32x4 s = gs[m][bj]; const f32x4 a0 = acc[ai][bj][m][0], a1 = acc[ai][bj][m][1];
                    u32x4 w;
                    w.x = cvt_pk_bf16(fmaxf(bf_lo(s.x), 1e-20f) * a0[0], fmaxf(bf_hi(s.x), 1e-20f) * a0[1]); w.y = cvt_pk_bf16(fmaxf(bf_lo(s.y), 1e-20f) * a0[2], fmaxf(bf_hi(s.y), 1e-20f) * a0[3]);
                    w.z = cvt_pk_bf16(fmaxf(bf_lo(s.z), 1e-20f) * a1[0], fmaxf(bf_hi(s.z), 1e-20f) * a1[1]); w.w = cvt_pk_bf16(fmaxf(bf_lo(s.w), 1e-20f) * a1[2], fmaxf(bf_hi(s.w), 1e-20f) * a1[3]);
                    st16_wt(MG + (size_t)(row0 + ai * HALF + m * 16) * 1024 + col0 + bj * HALF, w); }
            asm volatile("" ::: "memory");
        }
    }
};

template <bool ADD> struct EpiBranch {
    static constexpr bool PERM = true, AFTER_DRAIN = false, HAS_INIT = false, HAS_MID = false;
    bf16_t* MG; const bf16_t* G; int goff;
    __device__ __forceinline__ void operator()(const f32x4 (&acc)[2][2][4][2], const Unit& u, int wr, int wc, int fr, int fq) const {
        const int row0 = u.pm * BM + wr * 64 + fr; const int col0 = u.pn * BM + wc * 32 + 8 * fq;
#pragma unroll
        for (int ai = 0; ai < 2; ++ai) {
            u32x4 gw[4][2], old[4][2];
#pragma unroll
            for (int m = 0; m < 4; ++m)
#pragma unroll
                for (int bj = 0; bj < 2; ++bj) { const int row = row0 + ai * HALF + m * 16, col = col0 + bj * HALF;
                    gw[m][bj] = *(const u32x4*)(G + (size_t)row * 2048 + goff + col);
                    old[m][bj] = ADD ? *(const u32x4*)(MG + (size_t)row * 1024 + col) : (u32x4){0u, 0u, 0u, 0u}; }
#pragma unroll
            for (int m = 0; m < 4; ++m)
#pragma unroll
                for (int bj = 0; bj < 2; ++bj) { const int row = row0 + ai * HALF + m * 16, col = col0 + bj * HALF;
                    const u32x4 g = gw[m][bj], od = old[m][bj];
                    const f32x4 a0 = acc[ai][bj][m][0], a1 = acc[ai][bj][m][1];
                    float o[8];
                    o[0] = bf_lo(g.x) * a0[0]; o[1] = bf_hi(g.x) * a0[1]; o[2] = bf_lo(g.y) * a0[2]; o[3] = bf_hi(g.y) * a0[3];
                    o[4] = bf_lo(g.z) * a1[0]; o[5] = bf_hi(g.z) * a1[1]; o[6] = bf_lo(g.w) * a1[2]; o[7] = bf_hi(g.w) * a1[3];
                    if (ADD) { o[0] += bf_lo(od.x); o[1] += bf_hi(od.x); o[2] += bf_lo(od.y); o[3] += bf_hi(od.y); o[4] += bf_lo(od.z); o[5] += bf_hi(od.z); o[6] += bf_lo(od.w); o[7] += bf_hi(od.w); }
                    u32x4 w; w.x = cvt_pk_bf16(o[0], o[1]); w.y = cvt_pk_bf16(o[2], o[3]); w.z = cvt_pk_bf16(o[4], o[5]); w.w = cvt_pk_bf16(o[6], o[7]);
                    *(u32x4*)(MG + (size_t)row * 1024 + col) = w; }
        }
    }
};

template <class Epi, class Sched, bool ALIGN_EPI = false, bool SP2 = false>
__device__ __forceinline__ void gemm_phase(PG8_LAS unsigned char* lds, const Gemm g, const Sched& S, const Epi& E) {
    const int tid = threadIdx.x, wid = __builtin_amdgcn_readfirstlane(tid >> 6), lane = tid & 63, wr = wid >> 2, wc = wid & 3, fr = lane & 15, fq = lane >> 4;
    const int K = g.K, nt = K / BK;
    unsigned voffA[2], voffB[2];
#pragma unroll
    for (int i = 0; i < 2; ++i) { int R, C; stage_rc(tid * 16 + i * 8192, R, C); const int Rb = Epi::PERM ? ((R & ~31) + perm32(R & 31)) : R;
        voffA[i] = (unsigned)(R * K + C) * 2u; voffB[i] = (unsigned)(Rb * K + C) * 2u; }
    const size_t kstep = (size_t)(BK * 2);
    const size_t hstep = (size_t)HALF * K * 2;
    const size_t tstep = 2 * hstep;
    const unsigned ldsw = (unsigned)wid * 1024u;
    const int aoff = lds_byte(wr * 64 + fr, fq * 8), boff = lds_byte(wc * 32 + fr, fq * 8);
#define PG8_SA(b, h) (((b) * 2 + (h)) * HTB)
#define PG8_SB(b, h) ((4 + (b) * 2 + (h)) * HTB)
#define PG8_STAGE(bufoff, gbase, voff) do { _Pragma("unroll") for (int _i = 0; _i < 2; ++_i) \
        __builtin_amdgcn_global_load_lds((const unsigned*)((const char*)(gbase) + (voff)[_i]), (PG8_LAS unsigned*)(lds + (bufoff) + ldsw + _i * 8192), 16, 0, 0); } while (0)
#define PG8_LDA(dst, b, h) do { _Pragma("unroll") for (int m = 0; m < 4; ++m) _Pragma("unroll") for (int k = 0; k < 2; ++k) dst[m][k] = *(const PG8_LAS bf16x8*)(lds + PG8_SA(b, h) + aoff + m * 2048 + k * 1024); } while (0)
#define PG8_LDB(dst, b, h) do { _Pragma("unroll") for (int n = 0; n < 2; ++n) _Pragma("unroll") for (int k = 0; k < 2; ++k) dst[n][k] = *(const PG8_LAS bf16x8*)(lds + PG8_SB(b, h) + boff + n * 2048 + k * 1024); } while (0)
#define PG8_MMA(ai, bj, At, Bt) do { __builtin_amdgcn_s_setprio(1); _Pragma("unroll") for (int m = 0; m < 4; ++m) _Pragma("unroll") for (int n = 0; n < 2; ++n) _Pragma("unroll") for (int k = 0; k < 2; ++k) \
        acc[ai][bj][m][n] = __builtin_amdgcn_mfma_f32_16x16x32_bf16(Bt[n][k], At[m][k], acc[ai][bj][m][n], 0, 0, 0); __builtin_amdgcn_s_setprio(0); } while (0)
#define PG8_WAIT_V(n) asm volatile("s_waitcnt vmcnt(" #n ")" ::: "memory")
#define PG8_WAIT_L(n) asm volatile("s_waitcnt lgkmcnt(" #n ")" ::: "memory")
#define PG8_BAR __builtin_amdgcn_s_barrier()
#define PG8_SCHED __builtin_amdgcn_sched_barrier(0)
    Unit cur, nxt; int ui = 0;
    if (!S.next(0, cur)) return;
    f32x4 acc[2][2][4][2];
#pragma unroll
    for (int a = 0; a < 2; ++a)
#pragma unroll
        for (int b = 0; b < 2; ++b)
#pragma unroll
            for (int m = 0; m < 4; ++m)
#pragma unroll
                for (int n = 0; n < 2; ++n) acc[a][b][m][n] = (f32x4){0.f, 0.f, 0.f, 0.f};
    if constexpr (Epi::HAS_INIT) E.init(acc, cur, wr, wc, fr, fq);
    bf16x8 At[4][2], B0[2][2], B1[2][2];
    const char* cA = (const char*)g.A + (size_t)cur.pm * tstep; const char* cB = (const char*)g.Bt + (size_t)cur.pn * tstep;
    S.a_ready(cur);
    if constexpr (SP2) {
        PG8_STAGE(PG8_SB(0, 0), cB, voffB); PG8_STAGE(PG8_SB(0, 1), cB + hstep, voffB); PG8_STAGE(PG8_SA(0, 0), cA, voffA); PG8_STAGE(PG8_SA(0, 1), cA + hstep, voffA);
        if (wr == 1) PG8_BAR;
        PG8_WAIT_V(2); PG8_BAR;
        PG8_STAGE(PG8_SB(1, 0), cB + kstep, voffB); PG8_STAGE(PG8_SA(1, 0), cA + kstep, voffA); PG8_STAGE(PG8_SB(1, 1), cB + hstep + kstep, voffB);
        PG8_WAIT_V(6); PG8_BAR;
    } else {
        PG8_STAGE(PG8_SB(0, 0), cB, voffB); PG8_STAGE(PG8_SA(0, 0), cA, voffA); PG8_STAGE(PG8_SB(0, 1), cB + hstep, voffB); PG8_STAGE(PG8_SA(0, 1), cA + hstep, voffA);
        if (wr == 1) PG8_BAR;
        PG8_WAIT_V(4); PG8_BAR;
        PG8_STAGE(PG8_SB(1, 0), cB + kstep, voffB); PG8_STAGE(PG8_SA(1, 0), cA + kstep, voffA); PG8_STAGE(PG8_SB(1, 1), cB + hstep + kstep, voffB);
        PG8_WAIT_V(6); PG8_BAR;
    }
    for (;;) {
        const bool has_next = S.next(ui + 1, nxt);
        const char* nA = has_next ? (const char*)g.A + (size_t)nxt.pm * tstep : cA; const char* nB = has_next ? (const char*)g.Bt + (size_t)nxt.pn * tstep : cB;
        for (int t = 0; t < nt; t += 2) {
            const bool last = (t == nt - 2);
            if constexpr (Epi::HAS_MID) { if (t == E.mid_t) E.mid(acc, cur, wr, wc, fr, fq); }
            const char* a1 = cA + (size_t)(t + 1) * kstep;
            const char* a2 = last ? nA : cA + (size_t)(t + 2) * kstep; const char* b2 = last ? nB : cB + (size_t)(t + 2) * kstep;
            const char* a3 = a2 + kstep; const char* b3 = b2 + kstep;
            if (last && has_next) S.a_ready(nxt);
            if constexpr (SP2) {
            PG8_LDB(B0, 0, 0); PG8_LDB(B1, 0, 1); PG8_SCHED; PG8_LDA(At, 0, 0); PG8_STAGE(PG8_SA(1, 1), a1 + hstep, voffA);
            PG8_WAIT_V(8); PG8_WAIT_L(0); PG8_BAR; PG8_MMA(0, 0, At, B0); PG8_MMA(0, 1, At, B1); PG8_BAR; PG8_SCHED;
            PG8_LDA(At, 0, 1); PG8_STAGE(PG8_SB(0, 0), b2, voffB); PG8_STAGE(PG8_SB(0, 1), b2 + hstep, voffB); PG8_STAGE(PG8_SA(0, 0), a2, voffA);
            PG8_WAIT_V(8); PG8_WAIT_L(0); PG8_BAR; PG8_MMA(1, 0, At, B0); PG8_MMA(1, 1, At, B1); PG8_BAR; PG8_SCHED;
            PG8_LDB(B0, 1, 0); PG8_LDB(B1, 1, 1); PG8_SCHED; PG8_LDA(At, 1, 0); PG8_STAGE(PG8_SA(0, 1), a2 + hstep, voffA);
            PG8_WAIT_V(8); PG8_WAIT_L(0); PG8_BAR; PG8_MMA(0, 0, At, B0); PG8_MMA(0, 1, At, B1); PG8_BAR; PG8_SCHED;
            PG8_LDA(At, 1, 1); PG8_STAGE(PG8_SB(1, 0), b3, voffB); PG8_STAGE(PG8_SB(1, 1), b3 + hstep, voffB); PG8_STAGE(PG8_SA(1, 0), a3, voffA);
            PG8_WAIT_V(8); PG8_WAIT_L(0); PG8_BAR; PG8_MMA(1, 0, At, B0); PG8_MMA(1, 1, At, B1); PG8_BAR; PG8_SCHED;
            } else {
            PG8_LDB(B0, 0, 0); PG8_SCHED; PG8_LDA(At, 0, 0); PG8_STAGE(PG8_SA(1, 1), a1 + hstep, voffA);
            PG8_WAIT_L(8); PG8_BAR; PG8_WAIT_L(0); PG8_MMA(0, 0, At, B0); PG8_BAR; PG8_SCHED;
            PG8_LDB(B1, 0, 1); PG8_STAGE(PG8_SB(0, 0), b2, voffB);
            PG8_BAR; PG8_WAIT_L(0); PG8_MMA(0, 1, At, B1); PG8_BAR;
            PG8_LDA(At, 0, 1); PG8_STAGE(PG8_SA(0, 0), a2, voffA);
            PG8_BAR; PG8_WAIT_L(0); PG8_MMA(1, 0, At, B0); PG8_BAR; PG8_SCHED;
            PG8_STAGE(PG8_SB(0, 1), b2 + hstep, voffB);
            PG8_WAIT_V(6); PG8_BAR; PG8_MMA(1, 1, At, B1); PG8_BAR;
            PG8_LDB(B0, 1, 0); PG8_SCHED; PG8_LDA(At, 1, 0); PG8_STAGE(PG8_SA(0, 1), a2 + hstep, voffA);
            PG8_WAIT_L(8); PG8_BAR; PG8_WAIT_L(0); PG8_MMA(0, 0, At, B0); PG8_BAR; PG8_SCHED;
            PG8_LDB(B1, 1, 1); PG8_STAGE(PG8_SB(1, 0), b3, voffB);
            PG8_BAR; PG8_WAIT_L(0); PG8_MMA(0, 1, At, B1); PG8_BAR;
            PG8_LDA(At, 1, 1); PG8_STAGE(PG8_SA(1, 0), a3, voffA);
            PG8_BAR; PG8_WAIT_L(0); PG8_MMA(1, 0, At, B0); PG8_BAR; PG8_SCHED;
            PG8_STAGE(PG8_SB(1, 1), b3 + hstep, voffB);
            PG8_WAIT_V(6); PG8_BAR; PG8_MMA(1, 1, At, B1); PG8_BAR;
            }
        }
        if constexpr (ALIGN_EPI) { if (wr == 0) PG8_BAR; }
        if constexpr (!Epi::AFTER_DRAIN) { E(acc, cur, wr, wc, fr, fq); S.done(cur); }
        if (!has_next) break;
#pragma unroll
        for (int a = 0; a < 2; ++a)
#pragma unroll
            for (int b = 0; b < 2; ++b)
#pragma unroll
                for (int m = 0; m < 4; ++m)
#pragma unroll
                    for (int n = 0; n < 2; ++n) acc[a][b][m][n] = (f32x4){0.f, 0.f, 0.f, 0.f};
        if constexpr (Epi::HAS_INIT) E.init(acc, nxt, wr, wc, fr, fq);
        cur = nxt; cA = nA; cB = nB; ++ui;
        if constexpr (ALIGN_EPI) { if (wr == 1) PG8_BAR; }
    }
    PG8_WAIT_V(0);
    if constexpr (!ALIGN_EPI) { if (wr == 0) PG8_BAR; }
    PG8_BAR;
    if constexpr (Epi::AFTER_DRAIN) { E.fused(acc, cur, wr, wc, fr, fq, lds, wid, lane); S.done(cur); }
#undef PG8_SA
#undef PG8_SB
#undef PG8_STAGE
#undef PG8_LDA
#undef PG8_LDB
#undef PG8_MMA
#undef PG8_WAIT_V
#undef PG8_WAIT_L
#undef PG8_BAR
#undef PG8_SCHED
}
}


#ifndef NSYNC
#define NSYNC 1
#endif
#ifndef REPX
#define REPX 1
#endif
#define FUSE_FINAL 1
#ifndef WGM_WIDE
#define WGM_WIDE 4
#endif
#define USE_XCD_BAR 1
#ifndef REP4
#define REP4 1
#endif
#ifndef REP1
#define REP1 1
#endif
namespace cg = cooperative_groups;
#define LAS __attribute__((address_space(3)))
typedef unsigned short bf16;
typedef unsigned v4u __attribute__((ext_vector_type(4)));
typedef unsigned v2u __attribute__((ext_vector_type(2)));
typedef float f32x4 __attribute__((ext_vector_type(4)));
typedef float f32x16 __attribute__((ext_vector_type(16)));
typedef short bf16x8 __attribute__((ext_vector_type(8)));
typedef short s16x4 __attribute__((ext_vector_type(4)));

constexpr int NWAVES = 8, NTHREADS = 512;
constexpr int BATCH = 8, SEQ = 4096, DM = 1024, M = BATCH * SEQ;
constexpr int DFF = 2816, DIN = 4608, DATT = 512, DSGU = 512;
constexpr int NCHUNK = SEQ / 64;
constexpr size_t MiB = 1u << 20;
constexpr size_t WS_WGU1 = 0;
constexpr size_t WS_WD1  = WS_WGU1 + (size_t)2 * DFF * DM * 2;
constexpr size_t WS_WIN  = WS_WD1 + (size_t)DM * DFF * 2;
constexpr size_t WS_WBA  = WS_WIN + (size_t)DIN * DM * 2;
constexpr size_t WS_WBS  = WS_WBA + (size_t)DM * DATT * 2;
constexpr size_t WS_WOUT = WS_WBS + (size_t)DM * DSGU * 2;
constexpr size_t WS_WGU2 = WS_WOUT + (size_t)DM * DM * 2;
constexpr size_t WS_WD2  = WS_WGU2 + (size_t)2 * DFF * DM * 2;
constexpr size_t WS_WSGU = WS_WD2 + (size_t)DM * DFF * 2;
constexpr size_t WS_WEND = WS_WSGU + (size_t)8 * 128 * 128 * 2;
static_assert(WS_WEND <= 64 * MiB, "weights region");
constexpr size_t WS_XB   = 64 * MiB;
constexpr size_t WS_A1   = 128 * MiB;
constexpr size_t WS_QKV  = 128 * MiB;
constexpr size_t WS_MG   = 128 * MiB;
constexpr size_t WS_UV   = 224 * MiB;
constexpr size_t WS_GATES= 288 * MiB;
constexpr size_t WS_YATT = 416 * MiB;
constexpr size_t WS_YSGU = 448 * MiB;
constexpr size_t WS_SS   = 480 * MiB;
constexpr size_t SS_BYTES = (size_t)M * 16 * 4;
constexpr size_t WS_BAR  = WS_SS + 4 * SS_BYTES;
constexpr size_t WS_XBAR = WS_BAR + 256;
constexpr size_t WS_PCNT = WS_XBAR + 16384;
constexpr size_t WS_END  = WS_PCNT + 128 * 256;
static_assert(WS_A1 + (size_t)M * DFF * 2 <= WS_YATT && WS_END <= 496 * MiB, "ws map");

constexpr int LDS_BYTES = 147456;

__device__ __forceinline__ unsigned f2bf(float f) { unsigned u = __builtin_bit_cast(unsigned, f); return (u + 0x7fffu + ((u >> 16) & 1u)) >> 16; }
__device__ __forceinline__ unsigned pk2(float lo, float hi) { return f2bf(lo) | (f2bf(hi) << 16); }
__device__ __forceinline__ float wave_sum(float v) {
#pragma unroll
    for (int o = 1; o < 64; o <<= 1) v += __shfl_xor(v, o);
    return v;
}
#define LDS_WAIT() asm volatile("s_waitcnt lgkmcnt(0)" ::: "memory")

struct P0Item { const float* W; const float* gk; bf16* WT; int N, k0, n0, drow0, dpitch, koff; };
__device__ __forceinline__ void p0_set(P0Item& d, const float* W, const float* gk, bf16* WT, int K, int N, int r, int dpitch, int koff, int gu_sel) {
    const int nblk = N / 32, kb = r / nblk, n0 = 32 * (r % nblk);
    d.W = W; d.gk = gk; d.WT = WT; d.N = N; d.k0 = 64 * kb; d.n0 = n0; d.dpitch = dpitch ? dpitch : K; d.koff = koff;
    d.drow0 = gu_sel < 0 ? n0 : (n0 / 128) * 256 + gu_sel * 128 + (n0 % 128);
}
__device__ __forceinline__ void p0_load(const P0Item& d, float (&tv)[32], int lane) {
#pragma unroll
    for (int i = 0; i < 32; ++i) { const int kk = 2 * i + (lane >> 5); tv[i] = d.W[(size_t)(d.k0 + kk) * d.N + d.n0 + (lane & 31)]; }
}
__device__ __forceinline__ void p0_store(const P0Item& d, const float (&tv)[32], LAS float* scr, int lane) {
    const int c = lane & 7;
    f32x4 g0 = {1.f, 1.f, 1.f, 1.f}, g1 = g0;
    if (d.gk) { g0 = *(const f32x4*)(d.gk + d.k0 + 8 * c); g1 = *(const f32x4*)(d.gk + d.k0 + 8 * c + 4); }
#pragma unroll
    for (int i = 0; i < 32; ++i) { const int kk = 2 * i + (lane >> 5); scr[kk * 33 + (lane & 31)] = tv[i]; }
    LDS_WAIT(); asm volatile("" ::: "memory");
#pragma unroll
    for (int j = 0; j < 4; ++j) { const int n = (lane >> 3) + 8 * j; const LAS float* s = scr + (8 * c) * 33 + n;
        v4u o; o.x = pk2(s[0 * 33] * g0[0], s[1 * 33] * g0[1]); o.y = pk2(s[2 * 33] * g0[2], s[3 * 33] * g0[3]); o.z = pk2(s[4 * 33] * g1[0], s[5 * 33] * g1[1]); o.w = pk2(s[6 * 33] * g1[2], s[7 * 33] * g1[3]);
        *(v4u*)(d.WT + (size_t)(d.drow0 + n) * d.dpitch + d.koff + d.k0 + 8 * c) = o; }
    LDS_WAIT(); asm volatile("" ::: "memory");
}

struct Args { const float* in[21]; float* out; unsigned char* ws; int ph_lo, ph_hi; };

__device__ __forceinline__ void p0_prologue(const Args& a, LAS unsigned char* lds, int gw, int NGW, int wave, int lane) {
    LAS float* scr = (LAS float*)(lds + wave * 16384);
    unsigned char* ws = a.ws;
    constexpr int I_GU = (DM / 64) * (DFF / 32), I_D = (DFF / 64) * (DM / 32), I_IN = (DM / 64) * (DIN / 32), I_BR = (DATT / 64) * (DM / 32), I_OUT = (DM / 64) * (DM / 32);
    constexpr int NITEMS = 4 * I_GU + 2 * I_D + I_IN + 2 * I_BR + I_OUT;
    auto decode = [&](int it, P0Item& d) {
        int r = it;
        if (r < I_GU) { p0_set(d, a.in[2], a.in[1], (bf16*)(ws + WS_WGU1), DM, DFF, r, 0, 0, 0); return; } r -= I_GU;
        if (r < I_GU) { p0_set(d, a.in[3], a.in[1], (bf16*)(ws + WS_WGU1), DM, DFF, r, 0, 0, 1); return; } r -= I_GU;
        if (r < I_D)  { p0_set(d, a.in[4], nullptr, (bf16*)(ws + WS_WD1), DFF, DM, r, 0, 0, -1); return; } r -= I_D;
        if (r < I_IN) { p0_set(d, a.in[6], a.in[5], (bf16*)(ws + WS_WIN), DM, DIN, r, 0, 0, -1); return; } r -= I_IN;
        if (r < I_BR) { p0_set(d, a.in[13], nullptr, (bf16*)(ws + WS_WBA), DATT, DM, r, 1024, 0, -1); return; } r -= I_BR;
        if (r < I_BR) { p0_set(d, a.in[14], nullptr, (bf16*)(ws + WS_WBA), DSGU, DM, r, 1024, 512, -1); return; } r -= I_BR;
        if (r < I_OUT){ p0_set(d, a.in[15], nullptr, (bf16*)(ws + WS_WOUT), DM, DM, r, 0, 0, -1); return; } r -= I_OUT;
        if (r < I_GU) { p0_set(d, a.in[17], a.in[16], (bf16*)(ws + WS_WGU2), DM, DFF, r, 0, 0, 0); return; } r -= I_GU;
        if (r < I_GU) { p0_set(d, a.in[18], a.in[16], (bf16*)(ws + WS_WGU2), DM, DFF, r, 0, 0, 1); return; } r -= I_GU;
        p0_set(d, a.in[19], nullptr, (bf16*)(ws + WS_WD2), DFF, DM, r, 0, 0, -1);
    };
    if (gw < NITEMS) {
        float tv[32];
        { P0Item d; decode(gw, d); p0_load(d, tv, lane); }
        for (int it = gw; it < NITEMS; it += NGW) {
            const int nx = it + NGW; float tn[32];
            if (nx < NITEMS) { P0Item d; decode(nx, d); p0_load(d, tn, lane); }
            { P0Item d; decode(it, d); p0_store(d, tv, scr, lane); }
            if (nx < NITEMS) {
#pragma unroll
                for (int i = 0; i < 32; ++i) tv[i] = tn[i]; }
        }
    }
    { const float* w = a.in[11]; bf16* o = (bf16*)(ws + WS_WSGU);
      for (int i = gw * 64 + lane; i < 8 * 128 * 128 / 4; i += NGW * 64) { const f32x4 v = *(const f32x4*)(w + (size_t)i * 4); v2u p; p.x = pk2(v[0], v[1]); p.y = pk2(v[2], v[3]); *(v2u*)(o + (size_t)i * 4) = p; } }
    { const float* x = a.in[0]; bf16* xb = (bf16*)(ws + WS_XB); float* ss0 = (float*)(ws + WS_SS);
      static_assert((M / 2048) % 2 == 0, "two rows per step");
      for (int m = gw; m < M; m += 2 * NGW) {
          const int m2 = m + NGW;
          const f32x4* xr = (const f32x4*)(x + (size_t)m * DM) + lane; const f32x4* xr2 = (const f32x4*)(x + (size_t)m2 * DM) + lane; f32x4 v[4], w[4]; float s = 0.f, s2 = 0.f;
#pragma unroll
          for (int j = 0; j < 4; ++j) { v[j] = xr[64 * j]; w[j] = xr2[64 * j]; }
#pragma unroll
          for (int j = 0; j < 4; ++j) { s += (v[j][0] * v[j][0] + v[j][1] * v[j][1]) + (v[j][2] * v[j][2] + v[j][3] * v[j][3]); s2 += (w[j][0] * w[j][0] + w[j][1] * w[j][1]) + (w[j][2] * w[j][2] + w[j][3] * w[j][3]); }
          s = wave_sum(s); s2 = wave_sum(s2);
          v2u* o8 = (v2u*)(xb + (size_t)m * DM) + lane; v2u* o82 = (v2u*)(xb + (size_t)m2 * DM) + lane;
#pragma unroll
          for (int j = 0; j < 4; ++j) { v2u p; p.x = pk2(v[j][0], v[j][1]); p.y = pk2(v[j][2], v[j][3]); o8[64 * j] = p; v2u p2; p2.x = pk2(w[j][0], w[j][1]); p2.y = pk2(w[j][2], w[j][3]); o82[64 * j] = p2; }
          if (lane < 16) { ss0[(size_t)m * 16 + lane] = lane == 0 ? s : 0.f; ss0[(size_t)m2 * 16 + lane] = lane == 0 ? s2 : 0.f; }
      } }
}

#define XB_TMO      128
#define XB_XCNT(j)  (256  + 64 * (j))
#define XB_XSUB(j)  (1280 + 64 * (j))
#define XB_XGEN(j)  (2304 + 64 * (j))
#define XB_TOP      3328
#define XB_TOPGEN   3392
#define XCD_BAR_WORDS 3456
#define XB_SPIN_CAP (1u << 18)

__device__ __forceinline__ unsigned xb_ld(unsigned* p)              { return __hip_atomic_load(p, __ATOMIC_RELAXED, __HIP_MEMORY_SCOPE_AGENT); }
__device__ __forceinline__ unsigned xb_add(unsigned* p, unsigned v) { return __hip_atomic_fetch_add(p, v, __ATOMIC_RELAXED, __HIP_MEMORY_SCOPE_AGENT); }
__device__ __forceinline__ unsigned xb_xcc_id() { return (unsigned)__builtin_amdgcn_s_getreg((3 << 11) | 20) & 0xFu; }
#define XB_SPIN(cond, bar) do { unsigned _sp = 0; while (cond) { __builtin_amdgcn_s_sleep(1); \
    if ((++_sp & 255u) == 0u) { if (xb_ld(&(bar)[XB_TMO])) break; if (_sp > XB_SPIN_CAP) { atomicAdd(&(bar)[XB_TMO], 1u); break; } } } } while (0)

struct XcdBarrier {
    unsigned* bar; unsigned x;
    volatile LAS unsigned* st;
};

__device__ __forceinline__ XcdBarrier xcd_barrier_post(unsigned* bar, volatile LAS unsigned* st) {
    XcdBarrier b; b.bar = bar; b.x = xb_xcc_id(); b.st = st;
    if (threadIdx.x == 0) (void)xb_add(&bar[XB_XCNT(b.x)], 1u);
    return b;
}
__device__ __forceinline__ void xcd_barrier_complete(unsigned* bar, unsigned x, unsigned& nloc, unsigned& nx) {
    const unsigned G = gridDim.x * gridDim.y * gridDim.z;
    unsigned sum, cnt, mine, sp = 0u;
    for (;;) {
        sum = 0u; cnt = 0u; mine = 0u;
#pragma unroll
        for (unsigned j = 0; j < 16; ++j) { const unsigned c = xb_ld(&bar[XB_XCNT(j)]); sum += c; cnt += (c > 0u) ? 1u : 0u; mine = (j == x) ? c : mine; }
        if (sum == G) break;
        __builtin_amdgcn_s_sleep(1);
        if ((++sp & 255u) == 0u) { if (xb_ld(&bar[XB_TMO])) break; if (sp > XB_SPIN_CAP) { atomicAdd(&bar[XB_TMO], 1u); break; } }
    }
    nloc = mine > 0u ? mine : 1u; nx = cnt > 0u ? cnt : 1u;
}

__device__ __forceinline__ void xcd_barrier(const XcdBarrier& b) {
    asm volatile("s_waitcnt vmcnt(0)" ::: "memory");
    __syncthreads();
    if (threadIdx.x == 0) {
        unsigned* bar = b.bar;
        __builtin_amdgcn_s_waitcnt(0);
        unsigned nloc = b.st[0], nx = b.st[1];
        if (nloc == 0u) { xcd_barrier_complete(bar, b.x, nloc, nx); b.st[0] = nloc; b.st[1] = nx; }
        const unsigned old = xb_add(&bar[XB_XSUB(b.x)], 1u);
        const unsigned gen = old / nloc;
        if (old + 1u == (gen + 1u) * nloc) {
            __builtin_amdgcn_fence(__ATOMIC_RELEASE, "agent");
            asm volatile("s_waitcnt vmcnt(0)" ::: "memory");
            const unsigned og = xb_add(&bar[XB_TOP], 1u);
            const unsigned tg = og / nx;
            if (og + 1u == (tg + 1u) * nx) xb_add(&bar[XB_TOPGEN], 1u);
            else XB_SPIN(xb_ld(&bar[XB_TOPGEN]) == tg, bar);
            __builtin_amdgcn_fence(__ATOMIC_ACQUIRE, "agent");
            xb_add(&bar[XB_XGEN(b.x)], 1u);
            asm volatile("s_waitcnt vmcnt(0)" ::: "memory");
        } else {
            XB_SPIN(xb_ld(&bar[XB_XGEN(b.x)]) == gen, bar);
            __builtin_amdgcn_fence(__ATOMIC_ACQUIRE, "agent");
            asm volatile("s_waitcnt vmcnt(0)" ::: "memory");
        }
    }
    __syncthreads();
}

__device__ __forceinline__ void grid_bar(unsigned* cnt, unsigned target) {
    asm volatile("s_waitcnt vmcnt(0)" ::: "memory");
    __syncthreads();
    if (threadIdx.x == 0) {
        __builtin_amdgcn_fence(__ATOMIC_RELEASE, "agent");
        asm volatile("s_waitcnt vmcnt(0)" ::: "memory");
        __hip_atomic_fetch_add(cnt, 1u, __ATOMIC_RELAXED, __HIP_MEMORY_SCOPE_AGENT);
        unsigned sp = 0;
        while (__hip_atomic_load(cnt, __ATOMIC_RELAXED, __HIP_MEMORY_SCOPE_AGENT) < target) { __builtin_amdgcn_s_sleep(2); if (++sp > (1u << 22)) break; }
        __builtin_amdgcn_fence(__ATOMIC_ACQUIRE, "agent");
        asm volatile("s_waitcnt vmcnt(0)" ::: "memory");
    }
    __syncthreads();
}

#define MFMA32(a, b, c) __builtin_amdgcn_mfma_f32_32x32x16_bf16((a), (b), (c), 0, 0, 0)
constexpr int KV_PITCH = 144;
constexpr int KV_TILE = 64 * KV_PITCH;
constexpr int ATT_NSLOT = 6;
constexpr int ATT_K0 = 0, ATT_V0 = ATT_NSLOT * KV_TILE, ATT_TAB = 2 * ATT_NSLOT * KV_TILE;
__device__ __forceinline__ s16x4 tr_read(unsigned lds_addr) { s16x4 r; asm volatile("ds_read_b64_tr_b16 %0, %1\n\ts_waitcnt lgkmcnt(0)" : "=&v"(r) : "v"(lds_addr) : "memory"); return r; }

__device__ __forceinline__ void attn_tile(const LAS unsigned char* Kb, unsigned Vaddr, const LAS float* tb, const bf16x8 (&qf)[4], unsigned krd, float& mrun, float& lrun, f32x16& o0, f32x16& o1) {
    f32x16 p0, p1;
#pragma unroll
    for (int r = 0; r < 16; ++r) { const int o = (r & 3) + 8 * (r >> 2); p0[r] = tb[o]; p1[r] = tb[o + 32]; }
#pragma unroll
    for (int ks = 0; ks < 4; ++ks) {
        const bf16x8 k0 = *(const LAS bf16x8*)(Kb + krd + ks * 32), k1 = *(const LAS bf16x8*)(Kb + krd + 32 * KV_PITCH + ks * 32);
        p0 = MFMA32(k0, qf[ks], p0); p1 = MFMA32(k1, qf[ks], p1);
    }
    s16x4 vt[16];
    asm volatile(
        "ds_read_b64_tr_b16 %0, %16 offset:0\n\tds_read_b64_tr_b16 %1, %16 offset:1152\n\tds_read_b64_tr_b16 %2, %16 offset:64\n\tds_read_b64_tr_b16 %3, %16 offset:1216\n\t"
        "ds_read_b64_tr_b16 %4, %16 offset:2304\n\tds_read_b64_tr_b16 %5, %16 offset:3456\n\tds_read_b64_tr_b16 %6, %16 offset:2368\n\tds_read_b64_tr_b16 %7, %16 offset:3520\n\t"
        "ds_read_b64_tr_b16 %8, %16 offset:4608\n\tds_read_b64_tr_b16 %9, %16 offset:5760\n\tds_read_b64_tr_b16 %10, %16 offset:4672\n\tds_read_b64_tr_b16 %11, %16 offset:5824\n\t"
        "ds_read_b64_tr_b16 %12, %16 offset:6912\n\tds_read_b64_tr_b16 %13, %16 offset:8064\n\tds_read_b64_tr_b16 %14, %16 offset:6976\n\tds_read_b64_tr_b16 %15, %16 offset:8128\n\t"
        "s_waitcnt lgkmcnt(0)"
        : "=&v"(vt[0]), "=&v"(vt[1]), "=&v"(vt[2]), "=&v"(vt[3]), "=&v"(vt[4]), "=&v"(vt[5]), "=&v"(vt[6]), "=&v"(vt[7]),
          "=&v"(vt[8]), "=&v"(vt[9]), "=&v"(vt[10]), "=&v"(vt[11]), "=&v"(vt[12]), "=&v"(vt[13]), "=&v"(vt[14]), "=&v"(vt[15])
        : "v"(Vaddr) : "memory");
    float rm = p0[0];
#pragma unroll
    for (int r = 1; r < 16; ++r) rm = fmaxf(rm, p0[r]);
#pragma unroll
    for (int r = 0; r < 16; ++r) rm = fmaxf(rm, p1[r]);
    rm = fmaxf(rm, __shfl_xor(rm, 32));
    if (__builtin_amdgcn_ballot_w64(rm > mrun + 8.0f) != 0ull) {
        const float mnew = fmaxf(mrun, rm), sc = __builtin_amdgcn_exp2f(mrun - mnew); mrun = mnew; lrun *= sc;
#pragma unroll
        for (int r = 0; r < 16; ++r) { o0[r] *= sc; o1[r] *= sc; }
    }
    float ls = 0.f;
#pragma unroll
    for (int r = 0; r < 16; ++r) { p0[r] = __builtin_amdgcn_exp2f(p0[r] - mrun); p1[r] = __builtin_amdgcn_exp2f(p1[r] - mrun); ls += p0[r] + p1[r]; }
    lrun += ls;
#pragma unroll
    for (int s = 0; s < 4; ++s) {
        v4u pw;
        if (s < 2) { pw.x = pg8::cvt_pk_bf16(p0[8 * s + 0], p0[8 * s + 1]); pw.y = pg8::cvt_pk_bf16(p0[8 * s + 2], p0[8 * s + 3]); pw.z = pg8::cvt_pk_bf16(p0[8 * s + 4], p0[8 * s + 5]); pw.w = pg8::cvt_pk_bf16(p0[8 * s + 6], p0[8 * s + 7]); }
        else { const int s2 = s - 2; pw.x = pg8::cvt_pk_bf16(p1[8 * s2 + 0], p1[8 * s2 + 1]); pw.y = pg8::cvt_pk_bf16(p1[8 * s2 + 2], p1[8 * s2 + 3]); pw.z = pg8::cvt_pk_bf16(p1[8 * s2 + 4], p1[8 * s2 + 5]); pw.w = pg8::cvt_pk_bf16(p1[8 * s2 + 6], p1[8 * s2 + 7]); }
        const bf16x8 pf = __builtin_bit_cast(bf16x8, pw);
        const bf16x8 v0 = __builtin_shufflevector(vt[4 * s + 0], vt[4 * s + 1], 0, 1, 2, 3, 4, 5, 6, 7), v1 = __builtin_shufflevector(vt[4 * s + 2], vt[4 * s + 3], 0, 1, 2, 3, 4, 5, 6, 7);
        o0 = MFMA32(v0, pf, o0); o1 = MFMA32(v1, pf, o1);
    }
}

__device__ __forceinline__ void attn_unit(int b, int h, int c0, const bf16* QKV, bf16* YATT, const float* relb, LAS unsigned char* lds, int tid, int wave, int lane) {
    const int l31 = lane & 31, hi = lane >> 5;
    const size_t tok0 = (size_t)b * SEQ;
    const int T0 = c0 - 8;
    const int srow = tid >> 3, sch = tid & 7;
    const bf16* kg = QKV + (tok0 + srow) * 1536 + 512 + h * 64 + sch * 8 + (long)T0 * 64 * 1536;
    const bf16* vg = kg + 512;
    const unsigned soff = srow * KV_PITCH + sch * 16;
#define ATT_LOAD(KR, VR, rel) do { const long c_ = (T0 + (rel)) < 0 ? -(long)T0 : (long)(rel); KR = *(const v4u*)(kg + c_ * 64 * 1536); VR = *(const v4u*)(vg + c_ * 64 * 1536); } while (0)
#define ATT_WRITE(KR, VR, rel) do { const int sl_ = (rel) % ATT_NSLOT; *(LAS v4u*)(lds + ATT_K0 + sl_ * KV_TILE + soff) = KR; *(LAS v4u*)(lds + ATT_V0 + sl_ * KV_TILE + soff) = VR; } while (0)
    v4u kA, vA, kB, vB, k0r, v0r, k1r, v1r, k2r, v2r, k3r, v3r;
    ATT_LOAD(k0r, v0r, 0); ATT_LOAD(k1r, v1r, 1); ATT_LOAD(k2r, v2r, 2); ATT_LOAD(k3r, v3r, 3); ATT_LOAD(kA, vA, 4); ATT_LOAD(kB, vB, 5);
    LAS float* tab = (LAS float*)(lds + ATT_TAB);
    const int jw = wave >> 1;
    const int cc = c0 + jw;
    const int ql = 32 * (wave & 1) + l31;
    bf16x8 qf[4];
    { const bf16* qp = QKV + (tok0 + (size_t)cc * 64 + ql) * 1536 + h * 64 + hi * 8;
#pragma unroll
      for (int ks = 0; ks < 4; ++ks) qf[ks] = *(const bf16x8*)(qp + ks * 16); }
    float tbv[3];
#pragma unroll
    for (int k = 0; k < 3; ++k) { const int i = tid + k * NTHREADS; const int ic = i < 9 * 128 ? i : 0; const int dd = ic >> 7, t = ic & 127; int d = 64 * dd + 63 - t; d = d > 256 ? 256 : d; tbv[k] = relb[h * 513 + d + 256] * pg8::LOG2E; }
#pragma unroll
    for (int k = 0; k < 3; ++k) { const int i = tid + k * NTHREADS; if (i < 9 * 128) tab[i] = tbv[k]; }
    ATT_WRITE(k0r, v0r, 0); ATT_WRITE(k1r, v1r, 1); ATT_WRITE(k2r, v2r, 2); ATT_WRITE(k3r, v3r, 3);
    asm volatile("" : "+v"(qf[0]), "+v"(qf[1]), "+v"(qf[2]), "+v"(qf[3]));
    __syncthreads();
    float mrun = -1e30f, lrun = 0.f;
    f32x16 o0, o1;
#pragma unroll
    for (int r = 0; r < 16; ++r) { o0[r] = 0.f; o1[r] = 0.f; }
    const unsigned ldsb = (unsigned)(size_t)lds;
    const int i16 = lane & 15, tq = i16 >> 2, tp = i16 & 3, blk = (lane >> 4) & 1;
    const unsigned vrd = (4 * hi + tq) * KV_PITCH + 8 * (4 * blk + tp);
    const unsigned krd = l31 * KV_PITCH + 16 * hi;
    const int tbase = 63 - ql + 4 * hi;
#define ATT_STEP(s_, KR, VR) do { \
        const int rel_ = (s_) + jw; \
        if (T0 + rel_ >= 0) { const int sl_ = rel_ % ATT_NSLOT; \
            attn_tile(lds + ATT_K0 + sl_ * KV_TILE, ldsb + ATT_V0 + sl_ * KV_TILE + vrd, tab + (8 - (s_)) * 128 + tbase, qf, krd, mrun, lrun, o0, o1); } \
        if ((s_) + 4 <= 11) ATT_WRITE(KR, VR, (s_) + 4); \
        if ((s_) + 6 <= 11) ATT_LOAD(KR, VR, (s_) + 6); \
        asm volatile("s_waitcnt lgkmcnt(0)\n\ts_barrier" ::: "memory"); } while (0)
    ATT_STEP(0, kA, vA); ATT_STEP(1, kB, vB); ATT_STEP(2, kA, vA); ATT_STEP(3, kB, vB); ATT_STEP(4, kA, vA); ATT_STEP(5, kB, vB); ATT_STEP(6, kA, vA); ATT_STEP(7, kB, vB); ATT_STEP(8, kA, vA);
#undef ATT_STEP
#undef ATT_LOAD
#undef ATT_WRITE
    const float lt = lrun + __shfl_xor(lrun, 32); const float inv = __builtin_amdgcn_rcpf(lt);
    bf16* op = YATT + (tok0 + (size_t)cc * 64 + ql) * 1024 + h * 64 + 4 * hi;
#pragma unroll
    for (int g = 0; g < 4; ++g) {
        v2u w0, w1;
        w0.x = pg8::cvt_pk_bf16(o0[4 * g] * inv, o0[4 * g + 1] * inv); w0.y = pg8::cvt_pk_bf16(o0[4 * g + 2] * inv, o0[4 * g + 3] * inv);
        w1.x = pg8::cvt_pk_bf16(o1[4 * g] * inv, o1[4 * g + 1] * inv); w1.y = pg8::cvt_pk_bf16(o1[4 * g + 2] * inv, o1[4 * g + 3] * inv);
        *(v2u*)(op + 8 * g) = w0; *(v2u*)(op + 32 + 8 * g) = w1;
    }
}

__device__ __forceinline__ void sgu_unit(int b, int n, const bf16* UV, bf16* YSGU, const bf16* WS, const float* lng, const float* lnb, const float* bs, LAS unsigned char* lds, int wave, int lane) {
    const size_t tok0 = (size_t)b * SEQ + (size_t)n * 128;
    {
        float gg[8], bb[8];
#pragma unroll
        for (int i = 0; i < 8; ++i) { gg[i] = lng[8 * lane + i]; bb[i] = lnb[8 * lane + i]; }
        const int g = lane >> 3, d0 = 8 * (lane & 7);
        const bf16* vsp = UV + (tok0 + 16 * wave) * 1024 + 512 + 8 * lane;
        v4u rawA = *(const v4u*)vsp, rawB = *(const v4u*)(vsp + 1024);
#pragma unroll
        for (int rr = 0; rr < 16; rr += 2) {
            const int j = 16 * wave + rr;
            const v4u ra = rawA, rb = rawB;
            { const int nx = rr + 2 < 16 ? rr + 2 : rr; rawA = *(const v4u*)(vsp + (size_t)nx * 1024); rawB = *(const v4u*)(vsp + (size_t)(nx + 1) * 1024); }
            float xa[8], xb[8];
            xa[0] = pg8::bf_lo(ra.x); xa[1] = pg8::bf_hi(ra.x); xa[2] = pg8::bf_lo(ra.y); xa[3] = pg8::bf_hi(ra.y); xa[4] = pg8::bf_lo(ra.z); xa[5] = pg8::bf_hi(ra.z); xa[6] = pg8::bf_lo(ra.w); xa[7] = pg8::bf_hi(ra.w);
            xb[0] = pg8::bf_lo(rb.x); xb[1] = pg8::bf_hi(rb.x); xb[2] = pg8::bf_lo(rb.y); xb[3] = pg8::bf_hi(rb.y); xb[4] = pg8::bf_lo(rb.z); xb[5] = pg8::bf_hi(rb.z); xb[6] = pg8::bf_lo(rb.w); xb[7] = pg8::bf_hi(rb.w);
            float sa = 0.f, qa = 0.f, sb = 0.f, qb = 0.f;
#pragma unroll
            for (int i = 0; i < 8; ++i) { sa += xa[i]; qa += xa[i] * xa[i]; sb += xb[i]; qb += xb[i] * xb[i]; }
#pragma unroll
            for (int o = 1; o < 64; o <<= 1) { sa += __shfl_xor(sa, o); qa += __shfl_xor(qa, o); sb += __shfl_xor(sb, o); qb += __shfl_xor(qb, o); }
            const float mua = sa * (1.0f / 512.0f), mub = sb * (1.0f / 512.0f);
            const float ra_ = __builtin_amdgcn_rsqf(fmaxf(qa * (1.0f / 512.0f) - mua * mua, 0.f) + 1e-6f), rb_ = __builtin_amdgcn_rsqf(fmaxf(qb * (1.0f / 512.0f) - mub * mub, 0.f) + 1e-6f);
            v4u oa, ob;
            oa.x = pg8::cvt_pk_bf16((xa[0] - mua) * ra_ * gg[0] + bb[0], (xa[1] - mua) * ra_ * gg[1] + bb[1]); oa.y = pg8::cvt_pk_bf16((xa[2] - mua) * ra_ * gg[2] + bb[2], (xa[3] - mua) * ra_ * gg[3] + bb[3]);
            oa.z = pg8::cvt_pk_bf16((xa[4] - mua) * ra_ * gg[4] + bb[4], (xa[5] - mua) * ra_ * gg[5] + bb[5]); oa.w = pg8::cvt_pk_bf16((xa[6] - mua) * ra_ * gg[6] + bb[6], (xa[7] - mua) * ra_ * gg[7] + bb[7]);
            ob.x = pg8::cvt_pk_bf16((xb[0] - mub) * rb_ * gg[0] + bb[0], (xb[1] - mub) * rb_ * gg[1] + bb[1]); ob.y = pg8::cvt_pk_bf16((xb[2] - mub) * rb_ * gg[2] + bb[2], (xb[3] - mub) * rb_ * gg[3] + bb[3]);
            ob.z = pg8::cvt_pk_bf16((xb[4] - mub) * rb_ * gg[4] + bb[4], (xb[5] - mub) * rb_ * gg[5] + bb[5]); ob.w = pg8::cvt_pk_bf16((xb[6] - mub) * rb_ * gg[6] + bb[6], (xb[7] - mub) * rb_ * gg[7] + bb[7]);
            *(LAS v4u*)(lds + g * 16384 + j * 128 + d0 * 2) = oa; *(LAS v4u*)(lds + g * 16384 + (j + 1) * 128 + d0 * 2) = ob;
        }
    }
    __syncthreads();
    {
        const int g = wave, l31 = lane & 31, hi = lane >> 5;
        const int i16 = lane & 15, tq = i16 >> 2, tp = i16 & 3, blk = (lane >> 4) & 1;
        const unsigned img = (unsigned)(size_t)lds + g * 16384 + (8 * hi + tq) * 128 + 8 * (4 * blk + tp);
        const bf16* wg = WS + (size_t)g * 128 * 128;
#pragma unroll
        for (int it = 0; it < 4; ++it) {
            f32x16 c0, c1;
#pragma unroll
            for (int r = 0; r < 16; ++r) { c0[r] = 0.f; c1[r] = 0.f; }
            const int ns = it < 2 ? 4 : 8;
            const bf16* wp = wg + (size_t)(32 * it + l31) * 128 + 8 * hi;
            bf16x8 wfn = *(const bf16x8*)wp;
            const bf16* up = UV + (tok0 + 32 * it + l31) * 1024 + g * 64 + 4 * hi;
            v2u uu0[4], uu1[4];
#pragma unroll
            for (int q = 0; q < 4; ++q) { uu0[q] = *(const v2u*)(up + 8 * q); uu1[q] = *(const v2u*)(up + 32 + 8 * q); }
#pragma unroll
            for (int s = 0; s < 8; ++s) { if (s >= ns) break;
                const bf16x8 wf = wfn; wfn = *(const bf16x8*)(wp + 16 * (s + 1 < ns ? s + 1 : s));
                const unsigned va = img + (16 * s) * 128;
                s16x4 a0, a1, b0, b1;
                asm volatile("ds_read_b64_tr_b16 %0, %4 offset:0\n\tds_read_b64_tr_b16 %1, %4 offset:512\n\tds_read_b64_tr_b16 %2, %4 offset:64\n\tds_read_b64_tr_b16 %3, %4 offset:576\n\ts_waitcnt lgkmcnt(0)"
                             : "=&v"(a0), "=&v"(a1), "=&v"(b0), "=&v"(b1) : "v"(va) : "memory");
                const bf16x8 v0 = __builtin_shufflevector(a0, a1, 0, 1, 2, 3, 4, 5, 6, 7), v1 = __builtin_shufflevector(b0, b1, 0, 1, 2, 3, 4, 5, 6, 7);
                c0 = MFMA32(v0, wf, c0); c1 = MFMA32(v1, wf, c1);
            }
            const int i = 32 * it + l31; const float bsi = bs[g * 128 + i];
            bf16* yp = YSGU + (tok0 + i) * 1024 + 512 + g * 64 + 4 * hi;
#pragma unroll
            for (int q = 0; q < 4; ++q) {
                const v2u u0 = uu0[q], u1 = uu1[q];
                v2u w0, w1;
                w0.x = pg8::cvt_pk_bf16(pg8::bf_lo(u0.x) * (c0[4 * q] + bsi), pg8::bf_hi(u0.x) * (c0[4 * q + 1] + bsi)); w0.y = pg8::cvt_pk_bf16(pg8::bf_lo(u0.y) * (c0[4 * q + 2] + bsi), pg8::bf_hi(u0.y) * (c0[4 * q + 3] + bsi));
                w1.x = pg8::cvt_pk_bf16(pg8::bf_lo(u1.x) * (c1[4 * q] + bsi), pg8::bf_hi(u1.x) * (c1[4 * q + 1] + bsi)); w1.y = pg8::cvt_pk_bf16(pg8::bf_lo(u1.y) * (c1[4 * q + 2] + bsi), pg8::bf_hi(u1.y) * (c1[4 * q + 3] + bsi));
                *(v2u*)(yp + 8 * q) = w0; *(v2u*)(yp + 32 + 8 * q) = w1;
            }
        }
    }
    __syncthreads();
}

constexpr int N_PHASES = 10;
__global__ void __launch_bounds__(NTHREADS, 2) mega_fwd(Args args) {
    extern __shared__ __attribute__((aligned(16))) unsigned char lds_raw[];
    LAS unsigned char* lds = (LAS unsigned char*)lds_raw;
    const int tid = threadIdx.x, lane = tid & 63, wave = __builtin_amdgcn_readfirstlane(tid >> 6);
    const int G = gridDim.x, bx = blockIdx.x;
    const int vcu = (G % 8 == 0) ? (bx % 8) * (G / 8) + bx / 8 : bx;
    const int gw = vcu * NWAVES + wave, NGW = G * NWAVES;
    unsigned char* ws = args.ws;
    const int lo = args.ph_lo, hi = args.ph_hi;
    float* ss0 = (float*)(ws + WS_SS); float* ss1 = ss0 + (size_t)M * 16; float* ss2 = ss1 + (size_t)M * 16; float* ss3 = ss2 + (size_t)M * 16;
    bf16* XB = (bf16*)(ws + WS_XB); bf16* A1 = (bf16*)(ws + WS_A1);
    bf16* QKV = (bf16*)(ws + WS_QKV); bf16* UV = (bf16*)(ws + WS_UV); bf16* GATES = (bf16*)(ws + WS_GATES);
    bf16* YATT = (bf16*)(ws + WS_YATT); bf16* YSGU = (bf16*)(ws + WS_YATT); bf16* MG = (bf16*)(ws + WS_MG);
#define IN(k) (lo <= (k) && (k) < hi)
    unsigned* barcnt = (unsigned*)(ws + WS_BAR);
    unsigned bar_target = 0;
    volatile LAS unsigned* xst = (volatile LAS unsigned*)(lds + LDS_BYTES - 16);
    if (tid == 0) { xst[0] = 0u; xst[1] = 0u; }
    __syncthreads();
    XcdBarrier xbar; xbar.bar = (unsigned*)(ws + WS_XBAR); xbar.x = 0; xbar.st = xst;
#define SEAM(k) do { if (IN(k) && IN((k) + 1)) { if (lo != 0 || hi != N_PHASES) { cg::this_grid().sync(); } \
        else if (USE_XCD_BAR) xcd_barrier(xbar); else { bar_target += (unsigned)G; grid_bar(barcnt, bar_target); } } } while (0)

    if (lo == 0 && hi == N_PHASES) {
        if (bx == 0 && tid == 0) __hip_atomic_store((unsigned*)(ws + WS_BAR), 0u, __ATOMIC_RELAXED, __HIP_MEMORY_SCOPE_AGENT);
        if (bx == 0 && tid < 128) __hip_atomic_store((unsigned*)(ws + WS_PCNT) + 64 * tid, 0u, __ATOMIC_RELAXED, __HIP_MEMORY_SCOPE_AGENT);
        if (bx == 0) for (int i = tid; i < XCD_BAR_WORDS; i += NTHREADS) __hip_atomic_store((unsigned*)(ws + WS_XBAR) + i, 0u, __ATOMIC_RELAXED, __HIP_MEMORY_SCOPE_AGENT);
        cg::this_grid().sync();
        xbar = xcd_barrier_post((unsigned*)(ws + WS_XBAR), xst);
    }
    if (IN(0)) { p0_prologue(args, lds, gw, NGW, wave, lane); }
    SEAM(0);
    if (IN(1)) {
        pg8::Gemm g{XB, (const bf16*)(ws + WS_WGU1), M, 2 * DFF, DM}; pg8::StaticOrder S; S.init(M, 2 * DFF, G, bx, WGM_WIDE);
        pg8::EpiSwiglu E{A1, DFF, ss0};
        pg8::gemm_phase<pg8::EpiSwiglu, pg8::StaticOrder, true, true>(lds, g, S, E);
    }
    SEAM(1);
    if (IN(2)) {
        pg8::Gemm g{A1, (const bf16*)(ws + WS_WD1), M, DM, DFF}; pg8::StaticOrder S; S.init(M, DM, G, bx);
        pg8::EpiResid E{args.in[0], args.out, XB, ss1, 0.5f, 2.0f};
        pg8::gemm_phase<pg8::EpiResid, pg8::StaticOrder, true, true>(lds, g, S, E);
    }
    SEAM(2);
    if (IN(3)) {
        pg8::Gemm g{XB, (const bf16*)(ws + WS_WIN), M, DIN, DM}; pg8::StaticOrder S; S.init(M, DIN, G, bx, WGM_WIDE);
        pg8::EpiWin E{QKV, UV, GATES, args.in[7], ss1};
        pg8::gemm_phase<pg8::EpiWin, pg8::StaticOrder, true, true>(lds, g, S, E);
    }
    SEAM(3);
    if (IN(4)) {
        for (int u = vcu; u < BATCH * 8 * (NCHUNK / 4); u += G) {
            const int c4 = u % (NCHUNK / 4), bh = u / (NCHUNK / 4), h = bh % 8, b = bh / 8;
            attn_unit(b, h, 4 * c4, QKV, YATT, args.in[8], lds, tid, wave, lane);
        }
        for (int u = vcu; u < BATCH * (SEQ / 128); u += G) {
            sgu_unit(u / (SEQ / 128), u % (SEQ / 128), UV, YSGU, (const bf16*)(ws + WS_WSGU), args.in[9], args.in[10], args.in[12], lds, wave, lane);
        }
    }
    SEAM(4);
    if (IN(5)) {
        pg8::Gemm g{YATT, (const bf16*)(ws + WS_WBA), M, DM, DM}; pg8::StaticOrder S; S.init(M, DM, G, bx);
        pg8::EpiBranchCat E{MG, GATES, 8};
        pg8::gemm_phase<pg8::EpiBranchCat, pg8::StaticOrder, true, true>(lds, g, S, E);
    }
    SEAM(5);
    if (IN(6)) {
        pg8::Gemm g{MG, (const bf16*)(ws + WS_WOUT), M, DM, DM}; pg8::StaticOrder S; S.init(M, DM, G, bx);
        pg8::EpiResid E{args.out, args.out, XB, ss2, 1.0f, 1.0f};
        pg8::gemm_phase<pg8::EpiResid, pg8::StaticOrder, true, true>(lds, g, S, E);
    }
    SEAM(6);
    if (IN(7)) {
        pg8::Gemm g{XB, (const bf16*)(ws + WS_WGU2), M, 2 * DFF, DM}; pg8::StaticOrder S; S.init(M, 2 * DFF, G, bx, WGM_WIDE);
        pg8::EpiSwiglu E{A1, DFF, ss2};
        pg8::gemm_phase<pg8::EpiSwiglu, pg8::StaticOrder, true, true>(lds, g, S, E);
    }
    SEAM(7);
    if (IN(8)) {
        pg8::Gemm g{A1, (const bf16*)(ws + WS_WD2), M, DM, DFF}; pg8::StaticOrder S; S.init(M, DM, G, bx);
        pg8::EpiResidNorm E{args.out, args.out, ss3, (unsigned*)(ws + WS_PCNT), args.in[20], 0.5f, 2.0f};
        pg8::gemm_phase<pg8::EpiResidNorm, pg8::StaticOrder, true, true>(lds, g, S, E);
    }
    if (!FUSE_FINAL) SEAM(8);
    if (!FUSE_FINAL && IN(9)) {
        const float* gf = args.in[20]; f32x4 gv[4];
#pragma unroll
        for (int j = 0; j < 4; ++j) gv[j] = *((const f32x4*)gf + lane + 64 * j);
        for (int m = gw; m < M; m += NGW) {
            const float rs = pg8::row_rstd(ss3, m);
            f32x4* xr = (f32x4*)(args.out + (size_t)m * DM) + lane;
#pragma unroll
            for (int j = 0; j < 4; ++j) { f32x4 v = xr[64 * j]; v = v * rs * gv[j]; xr[64 * j] = v; }
        }
    }
#undef IN
#undef SEAM
}

#ifndef MK_MULTI
#define MK_MULTI 0
#endif
extern "C" void kernel_launch(void* const* d_in, const int* in_sizes, int n_in, void* d_out, int out_size, void* d_ws, size_t ws_size, hipStream_t stream) {
    static int grid = 0;
    if (grid == 0) {
        if (n_in != 21 || in_sizes[0] != M * DM || out_size != M * DM || ws_size < WS_END) { fprintf(stderr, "kernel_launch: unexpected shapes (n_in %d, in0 %d, out %d, ws %zu < %zu)\n", n_in, n_in > 0 ? in_sizes[0] : -1, out_size, ws_size, (size_t)WS_END); grid = -1; return; }
        int dev = 0, cus = 0, per_cu = 0;
        if (hipGetDevice(&dev) != hipSuccess || hipDeviceGetAttribute(&cus, hipDeviceAttributeMultiprocessorCount, dev) != hipSuccess) { grid = -1; return; }
        if (hipFuncSetAttribute((const void*)mega_fwd, hipFuncAttributeMaxDynamicSharedMemorySize, LDS_BYTES) != hipSuccess) { fprintf(stderr, "kernel_launch: hipFuncSetAttribute failed\n"); grid = -1; return; }
        if (hipOccupancyMaxActiveBlocksPerMultiprocessor(&per_cu, (const void*)mega_fwd, NTHREADS, LDS_BYTES) != hipSuccess || per_cu < 1) { fprintf(stderr, "kernel_launch: occupancy query says %d\n", per_cu); (void)hipGetLastError(); per_cu = 1; }
        grid = cus * 1;
    }
    if (grid < 0) return;
    Args a{};
    for (int i = 0; i < 21; ++i) a.in[i] = (const float*)d_in[i];
    a.out = (float*)d_out; a.ws = (unsigned char*)d_ws;
#if MK_MULTI
    for (int p = 0; p < N_PHASES; ++p) { a.ph_lo = p; a.ph_hi = p + 1; hipLaunchKernelGGL(mega_fwd, dim3(grid), dim3(NTHREADS), LDS_BYTES, stream, a); }
#else
    a.ph_lo = 0; a.ph_hi = N_PHASES;
    void* kargs[] = {&a};
    hipError_t e = hipLaunchCooperativeKernel((const void*)mega_fwd, dim3(grid), dim3(NTHREADS), kargs, LDS_BYTES, stream);
    if (e != hipSuccess) fprintf(stderr, "cooperative launch failed: %s (grid %d)\n", hipGetErrorString(e), grid);
#endif
}
```

```cpp
#include <hip/hip_runtime.h>
#include <hip/hip_cooperative_groups.h>
#include <cstdio>
#include <cstdint>
namespace pg8 {
#define PG8_LAS __attribute__((address_space(3)))
typedef unsigned short bf16_t;
typedef short bf16x8 __attribute__((ext_vector_type(8)));
typedef float f32x4 __attribute__((ext_vector_type(4)));
typedef unsigned u32x4 __attribute__((ext_vector_type(4)));
constexpr int BM = 256, BK = 64, HALF = 128, HTB = HALF * BK * 2  , STAGE_BYTES = 8 * HTB, NXCD = 8, WGM = 8;

__host__ __device__ __forceinline__ int lds_byte(int r, int c) { const int st = (r >> 4) * 2 + (c >> 5), rr = r & 15, cc = c & 31, ob = rr * 64 + cc * 2; return st * 1024 + (ob ^ (((ob >> 9) & 1) << 5)); }
__host__ __device__ __forceinline__ void stage_rc(int b, int& R, int& C) { const int st = b / 1024, sb = b % 1024, swz = sb ^ (((sb >> 9) & 1) << 5); R = (st >> 1) * 16 + swz / 64; C = (st & 1) * 32 + (swz % 64) / 2; }
__host__ __device__ __forceinline__ int perm32(int rho) { const int n = rho >> 4, i = rho & 15; return 8 * (i >> 2) + 4 * n + (i & 3); }

struct Unit { int pm, pn; };
struct Gemm { const bf16_t* A; const bf16_t* Bt; int M, N, K; };

struct StaticOrder {
    int nM, nN, nwg, G, c, wgm;
    __host__ __device__ void init(int M, int N, int G_, int c_, int wgm_ = WGM) { nM = M / BM; nN = N / BM; nwg = nM * nN; G = G_; c = c_; wgm = wgm_; }
    __host__ __device__ bool next(int i, Unit& u) const {
        const long L = (long)i * G + c; if (L >= nwg) return false;
        int wgid = (int)L; { const int q = nwg / NXCD, r = nwg % NXCD, xcd = wgid % NXCD, off = wgid / NXCD; wgid = (xcd < r ? xcd * (q + 1) : r * (q + 1) + (xcd - r) * q) + off; }
        const int nig = wgm * nN, gid = wgid / nig, fm = gid * wgm, gsz = (nM - fm) < wgm ? (nM - fm) : wgm;
        u.pm = fm + ((wgid % nig) % gsz); u.pn = (wgid % nig) / gsz; return true;
    }
    __device__ __forceinline__ void a_ready(const Unit&) const {}
    __device__ __forceinline__ void done(const Unit&) const {}
};


typedef float f32x2_t __attribute__((ext_vector_type(2))); typedef __bf16 bf16x2_t __attribute__((ext_vector_type(2)));
__device__ __forceinline__ unsigned cvt_pk_bf16(float lo, float hi) { f32x2_t v = {lo, hi}; bf16x2_t b = __builtin_convertvector(v, bf16x2_t); return __builtin_bit_cast(unsigned, b); }
__device__ __forceinline__ float bf_lo(unsigned w) { return __uint_as_float(w << 16); }
__device__ __forceinline__ float bf_hi(unsigned w) { return __uint_as_float(w & 0xffff0000u); }
__device__ __forceinline__ void st16_wt(void* p, u32x4 v) { __builtin_nontemporal_store(v, (u32x4*)p); }
__device__ __forceinline__ void st16_wt(void* p, f32x4 v) { __builtin_nontemporal_store(v, (f32x4*)p); }
constexpr float LOG2E = 1.4426950408889634f;
__device__ __forceinline__ float fsigmoid(float x) { return __builtin_amdgcn_rcpf(1.0f + __builtin_amdgcn_exp2f(-LOG2E * x)); }
__device__ __forceinline__ float row_rstd(const float* ss, int row) {
    const f32x4* p = (const f32x4*)(ss + (size_t)row * 16);
    const f32x4 a = p[0], b = p[1], c = p[2], d = p[3];
    const float s = ((a[0] + a[1]) + (a[2] + a[3])) + ((b[0] + b[1]) + (b[2] + b[3])) + ((c[0] + c[1]) + (c[2] + c[3])) + ((d[0] + d[1]) + (d[2] + d[3]));
    return __builtin_amdgcn_rsqf(s * (1.0f / 1024.0f) + 1e-6f);
}

__device__ __forceinline__ void rows_rstd(float (&rs)[2][4], const float* ss, int row0, int fq) {
    f32x4 p[2][4];
#pragma unroll
    for (int ai = 0; ai < 2; ++ai)
#pragma unroll
        for (int m = 0; m < 4; ++m) p[ai][m] = *(const f32x4*)(ss + (size_t)(row0 + ai * HALF + m * 16) * 16 + 4 * fq);
#pragma unroll
    for (int ai = 0; ai < 2; ++ai)
#pragma unroll
        for (int m = 0; m < 4; ++m) { float s = (p[ai][m][0] + p[ai][m][1]) + (p[ai][m][2] + p[ai][m][3]); s += __shfl_xor(s, 16); s += __shfl_xor(s, 32); rs[ai][m] = __builtin_amdgcn_rsqf(s * (1.0f / 1024.0f) + 1e-6f); }
}

struct EpiSwiglu {
    static constexpr bool PERM = true, AFTER_DRAIN = false, HAS_INIT = false, HAS_MID = false;
    bf16_t* O; int ldc; const float* ss;
    __device__ __forceinline__ void operator()(const f32x4 (&acc)[2][2][4][2], const Unit& u, int wr, int wc, int fr, int fq) const {
        const int row0 = u.pm * BM + wr * 64 + fr; const int col0 = u.pn * HALF + wc * 32 + 8 * fq;
        float rsv[2][4]; rows_rstd(rsv, ss, row0, fq);
#pragma unroll
        for (int ai = 0; ai < 2; ++ai)
#pragma unroll
            for (int m = 0; m < 4; ++m) {
                const int row = row0 + ai * HALF + m * 16; const float rs = rsv[ai][m];
                float o[8];
#pragma unroll
                for (int n = 0; n < 2; ++n)
#pragma unroll
                    for (int i = 0; i < 4; ++i) { const float g = acc[ai][0][m][n][i] * rs, up = acc[ai][1][m][n][i] * rs; o[4 * n + i] = g * fsigmoid(g) * up; }
                u32x4 w; w.x = cvt_pk_bf16(o[0], o[1]); w.y = cvt_pk_bf16(o[2], o[3]); w.z = cvt_pk_bf16(o[4], o[5]); w.w = cvt_pk_bf16(o[6], o[7]);
                st16_wt(O + (size_t)row * ldc + col0, w);
            }
    }
};

struct EpiResid {
    static constexpr bool PERM = true, AFTER_DRAIN = false, HAS_INIT = true, HAS_MID = false;
    const float* base; float* out; bf16_t* xb; float* ssout; float scale, inv_scale;
    __device__ __forceinline__ void init(f32x4 (&acc)[2][2][4][2], const Unit& u, int wr, int wc, int fr, int fq) const {
        const int row0 = u.pm * BM + wr * 64 + fr; const int col0 = u.pn * BM + wc * 32 + 8 * fq;
#pragma unroll
        for (int ai = 0; ai < 2; ++ai)
#pragma unroll
            for (int m = 0; m < 4; ++m) { const size_t off = (size_t)(row0 + ai * HALF + m * 16) * 1024 + col0;
#pragma unroll
                for (int bj = 0; bj < 2; ++bj)
#pragma unroll
                    for (int n = 0; n < 2; ++n) acc[ai][bj][m][n] = *(const f32x4*)(base + off + bj * HALF + n * 4) * inv_scale; }
    }
    __device__ __forceinline__ void operator()(const f32x4 (&acc)[2][2][4][2], const Unit& u, int wr, int wc, int fr, int fq) const {
        const int row0 = u.pm * BM + wr * 64 + fr; const int col0 = u.pn * BM + wc * 32 + 8 * fq;
#pragma unroll
        for (int ai = 0; ai < 2; ++ai)
#pragma unroll
            for (int m = 0; m < 4; ++m) {
                const int row = row0 + ai * HALF + m * 16; const size_t off = (size_t)row * 1024 + col0; float q = 0.f;
#pragma unroll
                for (int bj = 0; bj < 2; ++bj) {
                    const f32x4 v0 = acc[ai][bj][m][0] * scale, v1 = acc[ai][bj][m][1] * scale;
                    q += ((v0[0] * v0[0] + v0[1] * v0[1]) + (v0[2] * v0[2] + v0[3] * v0[3])) + ((v1[0] * v1[0] + v1[1] * v1[1]) + (v1[2] * v1[2] + v1[3] * v1[3]));
                    *(f32x4*)(out + off + bj * HALF) = v0; *(f32x4*)(out + off + bj * HALF + 4) = v1;
                    if (xb) { u32x4 w; w.x = cvt_pk_bf16(v0[0], v0[1]); w.y = cvt_pk_bf16(v0[2], v0[3]); w.z = cvt_pk_bf16(v1[0], v1[1]); w.w = cvt_pk_bf16(v1[2], v1[3]); *(u32x4*)(xb + off + bj * HALF) = w; }
                }
                q += __shfl_xor(q, 16); q += __shfl_xor(q, 32);
                if (fq == 0) ssout[(size_t)row * 16 + u.pn * 4 + wc] = q;
            }
    }
};

struct EpiResidNorm {
    static constexpr bool PERM = true, AFTER_DRAIN = false, HAS_INIT = true, HAS_MID = false;
    const float* base; float* out; float* ssx; unsigned* cnt; const float* gfin; float scale, inv_scale;
    __device__ __forceinline__ void init(f32x4 (&acc)[2][2][4][2], const Unit& u, int wr, int wc, int fr, int fq) const {
        const int row0 = u.pm * BM + wr * 64 + fr; const int col0 = u.pn * BM + wc * 32 + 8 * fq;
#pragma unroll
        for (int ai = 0; ai < 2; ++ai)
#pragma unroll
            for (int m = 0; m < 4; ++m) { const size_t off = (size_t)(row0 + ai * HALF + m * 16) * 1024 + col0;
#pragma unroll
                for (int bj = 0; bj < 2; ++bj)
#pragma unroll
                    for (int n = 0; n < 2; ++n) acc[ai][bj][m][n] = *(const f32x4*)(base + off + bj * HALF + n * 4) * inv_scale; }
    }
    __device__ __forceinline__ void operator()(f32x4 (&acc)[2][2][4][2], const Unit& u, int wr, int wc, int fr, int fq) const {
        const int row0 = u.pm * BM + wr * 64 + fr; const int col0 = u.pn * BM + wc * 32 + 8 * fq;
#pragma unroll
        for (int ai = 0; ai < 2; ++ai)
#pragma unroll
            for (int m = 0; m < 4; ++m) { float q = 0.f;
#pragma unroll
                for (int bj = 0; bj < 2; ++bj)
#pragma unroll
                    for (int n = 0; n < 2; ++n) { const f32x4 v = acc[ai][bj][m][n] * scale; acc[ai][bj][m][n] = v; q += (v[0] * v[0] + v[1] * v[1]) + (v[2] * v[2] + v[3] * v[3]); }
                q += __shfl_xor(q, 16); q += __shfl_xor(q, 32);
                if (fq == 0) __hip_atomic_store(ssx + (size_t)(row0 + ai * HALF + m * 16) * 16 + u.pn * 4 + wc, q, __ATOMIC_RELAXED, __HIP_MEMORY_SCOPE_AGENT); }
        asm volatile("s_waitcnt vmcnt(0)" ::: "memory");
        unsigned* c = cnt + 64 * u.pm;
        if (fr == 0 && fq == 0) __hip_atomic_fetch_add(c, 1u, __ATOMIC_RELAXED, __HIP_MEMORY_SCOPE_AGENT);
        { unsigned sp = 0; while (__hip_atomic_load(c, __ATOMIC_RELAXED, __HIP_MEMORY_SCOPE_AGENT) < 32u) { __builtin_amdgcn_s_sleep(1); if (++sp > (1u << 20)) break; } }
        asm volatile("" ::: "memory");
        f32x4 gf[2][2];
#pragma unroll
        for (int bj = 0; bj < 2; ++bj)
#pragma unroll
            for (int n = 0; n < 2; ++n) gf[bj][n] = *(const f32x4*)(gfin + col0 + bj * HALF + n * 4);
        float rs[2][4];
#pragma unroll
        for (int ai = 0; ai < 2; ++ai)
#pragma unroll
            for (int m = 0; m < 4; ++m) { const float* p = ssx + (size_t)(row0 + ai * HALF + m * 16) * 16 + 4 * fq;
                float s = (__hip_atomic_load(p, __ATOMIC_RELAXED, __HIP_MEMORY_SCOPE_AGENT) + __hip_atomic_load(p + 1, __ATOMIC_RELAXED, __HIP_MEMORY_SCOPE_AGENT))
                        + (__hip_atomic_load(p + 2, __ATOMIC_RELAXED, __HIP_MEMORY_SCOPE_AGENT) + __hip_atomic_load(p + 3, __ATOMIC_RELAXED, __HIP_MEMORY_SCOPE_AGENT));
                rs[ai][m] = s; }
#pragma unroll
        for (int ai = 0; ai < 2; ++ai)
#pragma unroll
            for (int m = 0; m < 4; ++m) { float s = rs[ai][m]; s += __shfl_xor(s, 16); s += __shfl_xor(s, 32); const float r = __builtin_amdgcn_rsqf(s * (1.0f / 1024.0f) + 1e-6f);
                const size_t off = (size_t)(row0 + ai * HALF + m * 16) * 1024 + col0;
#pragma unroll
                for (int bj = 0; bj < 2; ++bj)
#pragma unroll
                    for (int n = 0; n < 2; ++n) *(f32x4*)(out + off + bj * HALF + n * 4) = acc[ai][bj][m][n] * r * gf[bj][n]; }
    }
};

constexpr float QSCALE = 0.125f * LOG2E;
struct EpiWin {
    static constexpr bool PERM = true, AFTER_DRAIN = false, HAS_INIT = false, HAS_MID = false;
    bf16_t* QKV; bf16_t* UV; bf16_t* GATES; const float* bgate; const float* ss;
    template <int MODE> __device__ __forceinline__ void run(const f32x4 (&acc)[2][2][4][2], bf16_t* O, int ldc, int cbase, int row0, int ct) const {
        f32x4 bv[2][2];
#pragma unroll
        for (int bj = 0; bj < 2; ++bj)
#pragma unroll
            for (int n = 0; n < 2; ++n) bv[bj][n] = (MODE == 3) ? *(const f32x4*)(bgate + cbase + bj * HALF + ct + 4 * n) : (f32x4){0.f, 0.f, 0.f, 0.f};
        float rsv[2][4]; rows_rstd(rsv, ss, row0, ct >> 3 & 3);
#pragma unroll
        for (int ai = 0; ai < 2; ++ai)
#pragma unroll
            for (int m = 0; m < 4; ++m) {
                const int row = row0 + ai * HALF + m * 16; const float rs = rsv[ai][m];
#pragma unroll
                for (int bj = 0; bj < 2; ++bj) {
                    float o[8];
#pragma unroll
                    for (int n = 0; n < 2; ++n)
#pragma unroll
                        for (int i = 0; i < 4; ++i) {
                            float z = acc[ai][bj][m][n][i] * rs;
                            if (MODE == 0) z *= QSCALE;
                            else if (MODE == 2) { const float t = 1.5957691216f * (z + 0.044715f * z * z * z); z = z * fsigmoid(t); }
                            else if (MODE == 3) z = fsigmoid(z + bv[bj][n][i]);
                            o[4 * n + i] = z;
                        }
                    u32x4 w; w.x = cvt_pk_bf16(o[0], o[1]); w.y = cvt_pk_bf16(o[2], o[3]); w.z = cvt_pk_bf16(o[4], o[5]); w.w = cvt_pk_bf16(o[6], o[7]);
                    st16_wt(O + (size_t)row * ldc + cbase + bj * HALF + ct, w);
                }
            }
    }
    __device__ __forceinline__ void operator()(const f32x4 (&acc)[2][2][4][2], const Unit& u, int wr, int wc, int fr, int fq) const {
        const int row0 = u.pm * BM + wr * 64 + fr; const int ct = wc * 32 + 8 * fq; const int pn = u.pn;
        if (pn < 2) run<0>(acc, QKV, 1536, pn * BM, row0, ct);
        else if (pn < 6) run<1>(acc, QKV, 1536, pn * BM, row0, ct);
        else if (pn < 10) run<2>(acc, UV, 1024, pn * BM - 1536, row0, ct);
        else run<3>(acc, GATES, 2048, pn * BM - 2560, row0, ct);
    }
};

struct EpiBranchCat {
    static constexpr bool PERM = true, AFTER_DRAIN = false, HAS_INIT = false, HAS_MID = true;
    bf16_t* MG; const bf16_t* G; int mid_t;
    __device__ __forceinline__ void mid(f32x4 (&acc)[2][2][4][2], const Unit& u, int wr, int wc, int fr, int fq) const {
        int row0 = u.pm * BM + wr * 64 + fr; int col0 = u.pn * BM + wc * 32 + 8 * fq;
        asm volatile("" : "+v"(row0), "+v"(col0));
#pragma unroll
        for (int ai = 0; ai < 2; ++ai)
#pragma unroll
          for (int mh = 0; mh < 2; ++mh) {
            u32x4 ga[2][2], gs[2][2];
#pragma unroll
            for (int mm = 0; mm < 2; ++mm)
#pragma unroll
                for (int bj = 0; bj < 2; ++bj) { const bf16_t* gp = G + (size_t)(row0 + ai * HALF + (2 * mh + mm) * 16) * 2048 + col0 + bj * HALF; ga[mm][bj] = *(const u32x4*)gp; gs[mm][bj] = *(const u32x4*)(gp + 1024); }
#pragma unroll
            for (int mm = 0; mm < 2; ++mm)
#pragma unroll
                for (int bj = 0; bj < 2; ++bj) { const u32x4 a = ga[mm][bj], s = gs[mm][bj]; const int m = 2 * mh + mm;
                    f32x4 r0, r1;
                    r0[0] = bf_lo(a.x) * __builtin_amdgcn_rcpf(fmaxf(bf_lo(s.x), 1e-20f)); r0[1] = bf_hi(a.x) * __builtin_amdgcn_rcpf(fmaxf(bf_hi(s.x), 1e-20f));
                    r0[2] = bf_lo(a.y) * __builtin_amdgcn_rcpf(fmaxf(bf_lo(s.y), 1e-20f)); r0[3] = bf_hi(a.y) * __builtin_amdgcn_rcpf(fmaxf(bf_hi(s.y), 1e-20f));
                    r1[0] = bf_lo(a.z) * __builtin_amdgcn_rcpf(fmaxf(bf_lo(s.z), 1e-20f)); r1[1] = bf_hi(a.z) * __builtin_amdgcn_rcpf(fmaxf(bf_hi(s.z), 1e-20f));
                    r1[2] = bf_lo(a.w) * __builtin_amdgcn_rcpf(fmaxf(bf_lo(s.w), 1e-20f)); r1[3] = bf_hi(a.w) * __builtin_amdgcn_rcpf(fmaxf(bf_hi(s.w), 1e-20f));
                    acc[ai][bj][m][0] *= r0; acc[ai][bj][m][1] *= r1; }
            asm volatile("" ::: "memory");
          }
    }
    __device__ __forceinline__ void operator()(const f32x4 (&acc)[2][2][4][2], const Unit& u, int wr, int wc, int fr, int fq) const {
        const int row0 = u.pm * BM + wr * 64 + fr; const int col0 = u.pn * BM + wc * 32 + 8 * fq;
#pragma unroll
        for (int ai = 0; ai < 2; ++ai) {
            u32x4 gs[4][2];
#pragma unroll
            for (int m = 0; m < 4; ++m)
#pragma unroll
                for (int bj = 0; bj < 2; ++bj) gs[m][bj] = *(const u32x4*)(G + (size_t)(row0 + ai * HALF + m * 16) * 2048 + 1024 + col0 + bj * HALF);
#pragma unroll
            for (int m = 0; m < 4; ++m)
#pragma unroll
                for (int bj = 0; bj < 2; ++bj) { const u32x4 s = gs[m][bj]; const f32x4 a0 = acc[ai][bj][m][0], a1 = acc[ai][bj][m][1];
                    u32x4 w;
                    w.x = cvt_pk_bf16(fmaxf(bf_lo(s.x), 1e-20f) * a0[0], fmaxf(bf_hi(s.x), 1e-20f) * a0[1]); w.y = cvt_pk_bf16(fmaxf(bf_lo(s.y), 1e-20f) * a0[2], fmaxf(bf_hi(s.y), 1e-20f) * a0[3]);
                    w.z = cvt_pk_bf16(fmaxf(bf_lo(s.z), 1e-20f) * a1[0], fmaxf(bf_hi(s.z), 1e-20f) * a1[1]); w.w = cvt_pk_bf16(fmaxf(bf_lo(s.w), 1e-20f) * a1[2], fmaxf(bf_hi(s.w), 1e-20f) * a1[3]);
                    st16_wt(MG + (size_t)(row0 + ai * HALF + m * 16) * 1024 + col0 + bj * HALF, w); }
            asm volatile("" ::: "memory");
        }
    }
};

template <bool ADD> struct EpiBranch {
    static constexpr bool PERM = true, AFTER_DRAIN = false, HAS_INIT = false, HAS_MID = false;
    bf16_t* MG; const bf16_t* G; int goff;
    __device__ __forceinline__ void operator()(const f32x4 (&acc)[2][2][4][2], const Unit& u, int wr, int wc, int fr, int fq) const {
        const int row0 = u.pm * BM + wr * 64 + fr; const int col0 = u.pn * BM + wc * 32 + 8 * fq;
#pragma unroll
        for (int ai = 0; ai < 2; ++ai) {
            u32x4 gw[4][2], old[4][2];
#pragma unroll
            for (int m = 0; m < 4; ++m)
#pragma unroll
                for (int bj = 0; bj < 2; ++bj) { const int row = row0 + ai * HALF + m * 16, col = col0 + bj * HALF;
                    gw[m][bj] = *(const u32x4*)(G + (size_t)row * 2048 + goff + col);
                    old[m][bj] = ADD ? *(const u32x4*)(MG + (size_t)row * 1024 + col) : (u32x4){0u, 0u, 0u, 0u}; }
#pragma unroll
            for (int m = 0; m < 4; ++m)
#pragma unroll
                for (int bj = 0; bj < 2; ++bj) { const int row = row0 + ai * HALF + m * 16, col = col0 + bj * HALF;
                    const u32x4 g = gw[m][bj], od = old[m][bj];
                    const f32x4 a0 = acc[ai][bj][m][0], a1 = acc[ai][bj][m][1];
                    float o[8];
                    o[0] = bf_lo(g.x) * a0[0]; o[1] = bf_hi(g.x) * a0[1]; o[2] = bf_lo(g.y) * a0[2]; o[3] = bf_hi(g.y) * a0[3];
                    o[4] = bf_lo(g.z) * a1[0]; o[5] = bf_hi(g.z) * a1[1]; o[6] = bf_lo(g.w) * a1[2]; o[7] = bf_hi(g.w) * a1[3];
                    if (ADD) { o[0] += bf_lo(od.x); o[1] += bf_hi(od.x); o[2] += bf_lo(od.y); o[3] += bf_hi(od.y); o[4] += bf_lo(od.z); o[5] += bf_hi(od.z); o[6] += bf_lo(od.w); o[7] += bf_hi(od.w); }
                    u32x4 w; w.x = cvt_pk_bf16(o[0], o[1]); w.y = cvt_pk_bf16(o[2], o[3]); w.z = cvt_pk_bf16(o[4], o[5]); w.w = cvt_pk_bf16(o[6], o[7]);
                    *(u32x4*)(MG + (size_t)row * 1024 + col) = w; }
        }
    }
};

template <class Epi, class Sched, bool ALIGN_EPI = false, bool SP2 = false>
__device__ __forceinline__ void gemm_phase(PG8_LAS unsigned char* lds, const Gemm g, const Sched& S, const Epi& E) {
    const int tid = threadIdx.x, wid = __builtin_amdgcn_readfirstlane(tid >> 6), lane = tid & 63, wr = wid >> 2, wc = wid & 3, fr = lane & 15, fq = lane >> 4;
    const int K = g.K, nt = K / BK;
    unsigned voffA[2], voffB[2];
#pragma unroll
    for (int i = 0; i < 2; ++i) { int R, C; stage_rc(tid * 16 + i * 8192, R, C); const int Rb = Epi::PERM ? ((R & ~31) + perm32(R & 31)) : R;
        voffA[i] = (unsigned)(R * K + C) * 2u; voffB[i] = (unsigned)(Rb * K + C) * 2u; }
    const size_t kstep = (size_t)(BK * 2);
    const size_t hstep = (size_t)HALF * K * 2;
    const size_t tstep = 2 * hstep;
    const unsigned ldsw = (unsigned)wid * 1024u;
    const int aoff = lds_byte(wr * 64 + fr, fq * 8), boff = lds_byte(wc * 32 + fr, fq * 8);
#define PG8_SA(b, h) (((b) * 2 + (h)) * HTB)
#define PG8_SB(b, h) ((4 + (b) * 2 + (h)) * HTB)
#define PG8_STAGE(bufoff, gbase, voff) do { _Pragma("unroll") for (int _i = 0; _i < 2; ++_i) \
        __builtin_amdgcn_global_load_lds((const unsigned*)((const char*)(gbase) + (voff)[_i]), (PG8_LAS unsigned*)(lds + (bufoff) + ldsw + _i * 8192), 16, 0, 0); } while (0)
#define PG8_LDA(dst, b, h) do { _Pragma("unroll") for (int m = 0; m < 4; ++m) _Pragma("unroll") for (int k = 0; k < 2; ++k) dst[m][k] = *(const PG8_LAS bf16x8*)(lds + PG8_SA(b, h) + aoff + m * 2048 + k * 1024); } while (0)
#define PG8_LDB(dst, b, h) do { _Pragma("unroll") for (int n = 0; n < 2; ++n) _Pragma("unroll") for (int k = 0; k < 2; ++k) dst[n][k] = *(const PG8_LAS bf16x8*)(lds + PG8_SB(b, h) + boff + n * 2048 + k * 1024); } while (0)
#define PG8_MMA(ai, bj, At, Bt) do { __builtin_amdgcn_s_setprio(1); _Pragma("unroll") for (int m = 0; m < 4; ++m) _Pragma("unroll") for (int n = 0; n < 2; ++n) _Pragma("unroll") for (int k = 0; k < 2; ++k) \
        acc[ai][bj][m][n] = __builtin_amdgcn_mfma_f32_16x16x32_bf16(Bt[n][k], At[m][k], acc[ai][bj][m][n], 0, 0, 0); __builtin_amdgcn_s_setprio(0); } while (0)
#define PG8_WAIT_V(n) asm volatile("s_waitcnt vmcnt(" #n ")" ::: "memory")
#define PG8_WAIT_L(n) asm volatile("s_waitcnt lgkmcnt(" #n ")" ::: "memory")
#define PG8_BAR __builtin_amdgcn_s_barrier()
#define PG8_SCHED __builtin_amdgcn_sched_barrier(0)
    Unit cur, nxt; int ui = 0;
    if (!S.next(0, cur)) return;
    f32x4 acc[2][2][4][2];
#pragma unroll
    for (int a = 0; a < 2; ++a)
#pragma unroll
        for (int b = 0; b < 2; ++b)
#pragma unroll
            for (int m = 0; m < 4; ++m)
#pragma unroll
                for (int n = 0; n < 2; ++n) acc[a][b][m][n] = (f32x4){0.f, 0.f, 0.f, 0.f};
    if constexpr (Epi::HAS_INIT) E.init(acc, cur, wr, wc, fr, fq);
    bf16x8 At[4][2], B0[2][2], B1[2][2];
    const char* cA = (const char*)g.A + (size_t)cur.pm * tstep; const char* cB = (const char*)g.Bt + (size_t)cur.pn * tstep;
    S.a_ready(cur);
    if constexpr (SP2) {
        PG8_STAGE(PG8_SB(0, 0), cB, voffB); PG8_STAGE(PG8_SB(0, 1), cB + hstep, voffB); PG8_STAGE(PG8_SA(0, 0), cA, voffA); PG8_STAGE(PG8_SA(0, 1), cA + hstep, voffA);
        if (wr == 1) PG8_BAR;
        PG8_WAIT_V(2); PG8_BAR;
        PG8_STAGE(PG8_SB(1, 0), cB + kstep, voffB); PG8_STAGE(PG8_SA(1, 0), cA + kstep, voffA); PG8_STAGE(PG8_SB(1, 1), cB + hstep + kstep, voffB);
        PG8_WAIT_V(6); PG8_BAR;
    } else {
        PG8_STAGE(PG8_SB(0, 0), cB, voffB); PG8_STAGE(PG8_SA(0, 0), cA, voffA); PG8_STAGE(PG8_SB(0, 1), cB + hstep, voffB); PG8_STAGE(PG8_SA(0, 1), cA + hstep, voffA);
        if (wr == 1) PG8_BAR;
        PG8_WAIT_V(4); PG8_BAR;
        PG8_STAGE(PG8_SB(1, 0), cB + kstep, voffB); PG8_STAGE(PG8_SA(1, 0), cA + kstep, voffA); PG8_STAGE(PG8_SB(1, 1), cB + hstep + kstep, voffB);
        PG8_WAIT_V(6); PG8_BAR;
    }
    for (;;) {
        const bool has_next = S.next(ui + 1, nxt);
        const char* nA = has_next ? (const char*)g.A + (size_t)nxt.pm * tstep : cA; const char* nB = has_next ? (const char*)g.Bt + (size_t)nxt.pn * tstep : cB;
        for (int t = 0; t < nt; t += 2) {
            const bool last = (t == nt - 2);
            if constexpr (Epi::HAS_MID) { if (t == E.mid_t) E.mid(acc, cur, wr, wc, fr, fq); }
            const char* a1 = cA + (size_t)(t + 1) * kstep;
            const char* a2 = last ? nA : cA + (size_t)(t + 2) * kstep; const char* b2 = last ? nB : cB + (size_t)(t + 2) * kstep;
            const char* a3 = a2 + kstep; const char* b3 = b2 + kstep;
            if (last && has_next) S.a_ready(nxt);
            if constexpr (SP2) {
            PG8_LDB(B0, 0, 0); PG8_LDB(B1, 0, 1); PG8_SCHED; PG8_LDA(At, 0, 0); PG8_STAGE(PG8_SA(1, 1), a1 + hstep, voffA);
            PG8_WAIT_V(8); PG8_WAIT_L(0); PG8_BAR; PG8_MMA(0, 0, At, B0); PG8_MMA(0, 1, At, B1); PG8_BAR; PG8_SCHED;
            PG8_LDA(At, 0, 1); PG8_STAGE(PG8_SB(0, 0), b2, voffB); PG8_STAGE(PG8_SB(0, 1), b2 + hstep, voffB); PG8_STAGE(PG8_SA(0, 0), a2, voffA);
            PG8_WAIT_V(8); PG8_WAIT_L(0); PG8_BAR; PG8_MMA(1, 0, At, B0); PG8_MMA(1, 1, At, B1); PG8_BAR; PG8_SCHED;
            PG8_LDB(B0, 1, 0); PG8_LDB(B1, 1, 1); PG8_SCHED; PG8_LDA(At, 1, 0); PG8_STAGE(PG8_SA(0, 1), a2 + hstep, voffA);
            PG8_WAIT_V(8); PG8_WAIT_L(0); PG8_BAR; PG8_MMA(0, 0, At, B0); PG8_MMA(0, 1, At, B1); PG8_BAR; PG8_SCHED;
            PG8_LDA(At, 1, 1); PG8_STAGE(PG8_SB(1, 0), b3, voffB); PG8_STAGE(PG8_SB(1, 1), b3 + hstep, voffB); PG8_STAGE(PG8_SA(1, 0), a3, voffA);
            PG8_WAIT_V(8); PG8_WAIT_L(0); PG8_BAR; PG8_MMA(1, 0, At, B0); PG8_MMA(1, 1, At, B1); PG8_BAR; PG8_SCHED;
            } else {
            PG8_LDB(B0, 0, 0); PG8_SCHED; PG8_LDA(At, 0, 0); PG8_STAGE(PG8_SA(1, 1), a1 + hstep, voffA);
            PG8_WAIT_L(8); PG8_BAR; PG8_WAIT_L(0); PG8_MMA(0, 0, At, B0); PG8_BAR; PG8_SCHED;
            PG8_LDB(B1, 0, 1); PG8_STAGE(PG8_SB(0, 0), b2, voffB);
            PG8_BAR; PG8_WAIT_L(0); PG8_MMA(0, 1, At, B1); PG8_BAR;
            PG8_LDA(At, 0, 1); PG8_STAGE(PG8_SA(0, 0), a2, voffA);
            PG8_BAR; PG8_WAIT_L(0); PG8_MMA(1, 0, At, B0); PG8_BAR; PG8_SCHED;
            PG8_STAGE(PG8_SB(0, 1), b2 + hstep, voffB);
            PG8_WAIT_V(6); PG8_BAR; PG8_MMA(1, 1, At, B1); PG8_BAR;
            PG8_LDB(B0, 1, 0); PG8_SCHED; PG8_LDA(At, 1, 0); PG8_STAGE(PG8_SA(0, 1), a2 + hstep, voffA);
            PG8_WAIT_L(8); PG8_BAR; PG8_WAIT_L(0); PG8_MMA(0, 0, At, B0); PG8_BAR; PG8_SCHED;
            PG8_LDB(B1, 1, 1); PG8_STAGE(PG8_SB(1, 0), b3, voffB);
            PG8_BAR; PG8_WAIT_L(0); PG8_MMA(0, 1, At, B1); PG8_BAR;
            PG8_LDA(At, 1, 1); PG8_STAGE(PG8_SA(1, 0), a3, voffA);
            PG8_BAR; PG8_WAIT_L(0); PG8_MMA(1, 0, At, B0); PG8_BAR; PG8_SCHED;
            PG8_STAGE(PG8_SB(1, 1), b3 + hstep, voffB);
            PG8_WAIT_V(6); PG8_BAR; PG8_MMA(1, 1, At, B1); PG8_BAR;
            }
        }
        if constexpr (ALIGN_EPI) { if (wr == 0) PG8_BAR; }
        if constexpr (!Epi::AFTER_DRAIN) { E(acc, cur, wr, wc, fr, fq); S.done(cur); }
        if (!has_next) break;
#pragma unroll
        for (int a = 0; a < 2; ++a)
#pragma unroll
            for (int b = 0; b < 2; ++b)
#pragma unroll
                for (int m = 0; m < 4; ++m)
#pragma unroll
                    for (int n = 0; n < 2; ++n) acc[a][b][m][n] = (f32x4){0.f, 0.f, 0.f, 0.f};
        if constexpr (Epi::HAS_INIT) E.init(acc, nxt, wr, wc, fr, fq);
        cur = nxt; cA = nA; cB = nB; ++ui;
        if constexpr (ALIGN_EPI) { if (wr == 1) PG8_BAR; }
    }
    PG8_WAIT_V(0);
    if constexpr (!ALIGN_EPI) { if (wr == 0) PG8_BAR; }
    PG8_BAR;
    if constexpr (Epi::AFTER_DRAIN) { E.fused(acc, cur, wr, wc, fr, fq, lds, wid, lane); S.done(cur); }
#undef PG8_SA
#undef PG8_SB
#undef PG8_STAGE
#undef PG8_LDA
#undef PG8_LDB
#undef PG8_MMA
#undef PG8_WAIT_V
#undef PG8_WAIT_L
#undef PG8_BAR
#undef PG8_SCHED
}
}


#ifndef NSYNC
#define NSYNC 1
#endif
#ifndef REPX
#define REPX 1
#endif
#define FUSE_FINAL 1
#ifndef WGM_WIDE
#define WGM_WIDE 4
#endif
#define USE_XCD_BAR 1
#ifndef REP4
#define REP4 1
#endif
#ifndef REP1
#define REP1 1
#endif
namespace cg = cooperative_groups;
#define LAS __attribute__((address_space(3)))
typedef unsigned short bf16;
typedef unsigned v4u __attribute__((ext_vector_type(4)));
typedef unsigned v2u __attribute__((ext_vector_type(2)));
typedef float f32x4 __attribute__((ext_vector_type(4)));
typedef float f32x16 __attribute__((ext_vector_type(16)));
typedef short bf16x8 __attribute__((ext_vector_type(8)));
typedef short s16x4 __attribute__((ext_vector_type(4)));

constexpr int NWAVES = 8, NTHREADS = 512;
constexpr int BATCH = 8, SEQ = 4096, DM = 1024, M = BATCH * SEQ;
constexpr int DFF = 2816, DIN = 4608, DATT = 512, DSGU = 512;
constexpr int NCHUNK = SEQ / 64;
constexpr size_t MiB = 1u << 20;
constexpr size_t WS_WGU1 = 0;
constexpr size_t WS_WD1  = WS_WGU1 + (size_t)2 * DFF * DM * 2;
constexpr size_t WS_WIN  = WS_WD1 + (size_t)DM * DFF * 2;
constexpr size_t WS_WBA  = WS_WIN + (size_t)DIN * DM * 2;
constexpr size_t WS_WBS  = WS_WBA + (size_t)DM * DATT * 2;
constexpr size_t WS_WOUT = WS_WBS + (size_t)DM * DSGU * 2;
constexpr size_t WS_WGU2 = WS_WOUT + (size_t)DM * DM * 2;
constexpr size_t WS_WD2  = WS_WGU2 + (size_t)2 * DFF * DM * 2;
constexpr size_t WS_WSGU = WS_WD2 + (size_t)DM * DFF * 2;
constexpr size_t WS_WEND = WS_WSGU + (size_t)8 * 128 * 128 * 2;
static_assert(WS_WEND <= 64 * MiB, "weights region");
constexpr size_t WS_XB   = 64 * MiB;
constexpr size_t WS_A1   = 128 * MiB;
constexpr size_t WS_QKV  = 128 * MiB;
constexpr size_t WS_MG   = 128 * MiB;
constexpr size_t WS_UV   = 224 * MiB;
constexpr size_t WS_GATES= 288 * MiB;
constexpr size_t WS_YATT = 416 * MiB;
constexpr size_t WS_YSGU = 448 * MiB;
constexpr size_t WS_SS   = 480 * MiB;
constexpr size_t SS_BYTES = (size_t)M * 16 * 4;
constexpr size_t WS_BAR  = WS_SS + 4 * SS_BYTES;
constexpr size_t WS_XBAR = WS_BAR + 256;
constexpr size_t WS_PCNT = WS_XBAR + 16384;
constexpr size_t WS_END  = WS_PCNT + 128 * 256;
static_assert(WS_A1 + (size_t)M * DFF * 2 <= WS_YATT && WS_END <= 496 * MiB, "ws map");

constexpr int LDS_BYTES = 147456;

__device__ __forceinline__ unsigned f2bf(float f) { unsigned u = __builtin_bit_cast(unsigned, f); return (u + 0x7fffu + ((u >> 16) & 1u)) >> 16; }
__device__ __forceinline__ unsigned pk2(float lo, float hi) { return f2bf(lo) | (f2bf(hi) << 16); }
__device__ __forceinline__ float wave_sum(float v) {
#pragma unroll
    for (int o = 1; o < 64; o <<= 1) v += __shfl_xor(v, o);
    return v;
}
#define LDS_WAIT() asm volatile("s_waitcnt lgkmcnt(0)" ::: "memory")

struct P0Item { const float* W; const float* gk; bf16* WT; int N, k0, n0, drow0, dpitch, koff; };
__device__ __forceinline__ void p0_set(P0Item& d, const float* W, const float* gk, bf16* WT, int K, int N, int r, int dpitch, int koff, int gu_sel) {
    const int nblk = N / 32, kb = r / nblk, n0 = 32 * (r % nblk);
    d.W = W; d.gk = gk; d.WT = WT; d.N = N; d.k0 = 64 * kb; d.n0 = n0; d.dpitch = dpitch ? dpitch : K; d.koff = koff;
    d.drow0 = gu_sel < 0 ? n0 : (n0 / 128) * 256 + gu_sel * 128 + (n0 % 128);
}
__device__ __forceinline__ void p0_load(const P0Item& d, float (&tv)[32], int lane) {
#pragma unroll
    for (int i = 0; i < 32; ++i) { const int kk = 2 * i + (lane >> 5); tv[i] = d.W[(size_t)(d.k0 + kk) * d.N + d.n0 + (lane & 31)]; }
}
__device__ __forceinline__ void p0_store(const P0Item& d, const float (&tv)[32], LAS float* scr, int lane) {
    const int c = lane & 7;
    f32x4 g0 = {1.f, 1.f, 1.f, 1.f}, g1 = g0;
    if (d.gk) { g0 = *(const f32x4*)(d.gk + d.k0 + 8 * c); g1 = *(const f32x4*)(d.gk + d.k0 + 8 * c + 4); }
#pragma unroll
    for (int i = 0; i < 32; ++i) { const int kk = 2 * i + (lane >> 5); scr[kk * 33 + (lane & 31)] = tv[i]; }
    LDS_WAIT(); asm volatile("" ::: "memory");
#pragma unroll
    for (int j = 0; j < 4; ++j) { const int n = (lane >> 3) + 8 * j; const LAS float* s = scr + (8 * c) * 33 + n;
        v4u o; o.x = pk2(s[0 * 33] * g0[0], s[1 * 33] * g0[1]); o.y = pk2(s[2 * 33] * g0[2], s[3 * 33] * g0[3]); o.z = pk2(s[4 * 33] * g1[0], s[5 * 33] * g1[1]); o.w = pk2(s[6 * 33] * g1[2], s[7 * 33] * g1[3]);
        *(v4u*)(d.WT + (size_t)(d.drow0 + n) * d.dpitch + d.koff + d.k0 + 8 * c) = o; }
    LDS_WAIT(); asm volatile("" ::: "memory");
}

struct Args { const float* in[21]; float* out; unsigned char* ws; int ph_lo, ph_hi; };

__device__ __forceinline__ void p0_prologue(const Args& a, LAS unsigned char* lds, int gw, int NGW, int wave, int lane) {
    LAS float* scr = (LAS float*)(lds + wave * 16384);
    unsigned char* ws = a.ws;
    constexpr int I_GU = (DM / 64) * (DFF / 32), I_D = (DFF / 64) * (DM / 32), I_IN = (DM / 64) * (DIN / 32), I_BR = (DATT / 64) * (DM / 32), I_OUT = (DM / 64) * (DM / 32);
    constexpr int NITEMS = 4 * I_GU + 2 * I_D + I_IN + 2 * I_BR + I_OUT;
    auto decode = [&](int it, P0Item& d) {
        int r = it;
        if (r < I_GU) { p0_set(d, a.in[2], a.in[1], (bf16*)(ws + WS_WGU1), DM, DFF, r, 0, 0, 0); return; } r -= I_GU;
        if (r < I_GU) { p0_set(d, a.in[3], a.in[1], (bf16*)(ws + WS_WGU1), DM, DFF, r, 0, 0, 1); return; } r -= I_GU;
        if (r < I_D)  { p0_set(d, a.in[4], nullptr, (bf16*)(ws + WS_WD1), DFF, DM, r, 0, 0, -1); return; } r -= I_D;
        if (r < I_IN) { p0_set(d, a.in[6], a.in[5], (bf16*)(ws + WS_WIN), DM, DIN, r, 0, 0, -1); return; } r -= I_IN;
        if (r < I_BR) { p0_set(d, a.in[13], nullptr, (bf16*)(ws + WS_WBA), DATT, DM, r, 1024, 0, -1); return; } r -= I_BR;
        if (r < I_BR) { p0_set(d, a.in[14], nullptr, (bf16*)(ws + WS_WBA), DSGU, DM, r, 1024, 512, -1); return; } r -= I_BR;
        if (r < I_OUT){ p0_set(d, a.in[15], nullptr, (bf16*)(ws + WS_WOUT), DM, DM, r, 0, 0, -1); return; } r -= I_OUT;
        if (r < I_GU) { p0_set(d, a.in[17], a.in[16], (bf16*)(ws + WS_WGU2), DM, DFF, r, 0, 0, 0); return; } r -= I_GU;
        if (r < I_GU) { p0_set(d, a.in[18], a.in[16], (bf16*)(ws + WS_WGU2), DM, DFF, r, 0, 0, 1); return; } r -= I_GU;
        p0_set(d, a.in[19], nullptr, (bf16*)(ws + WS_WD2), DFF, DM, r, 0, 0, -1);
    };
    if (gw < NITEMS) {
        float tv[32];
        { P0Item d; decode(gw, d); p0_load(d, tv, lane); }
        for (int it = gw; it < NITEMS; it += NGW) {
            const int nx = it + NGW; float tn[32];
            if (nx < NITEMS) { P0Item d; decode(nx, d); p0_load(d, tn, lane); }
            { P0Item d; decode(it, d); p0_store(d, tv, scr, lane); }
            if (nx < NITEMS) {
#pragma unroll
                for (int i = 0; i < 32; ++i) tv[i] = tn[i]; }
        }
    }
    { const float* w = a.in[11]; bf16* o = (bf16*)(ws + WS_WSGU);
      for (int i = gw * 64 + lane; i < 8 * 128 * 128 / 4; i += NGW * 64) { const f32x4 v = *(const f32x4*)(w + (size_t)i * 4); v2u p; p.x = pk2(v[0], v[1]); p.y = pk2(v[2], v[3]); *(v2u*)(o + (size_t)i * 4) = p; } }
    { const float* x = a.in[0]; bf16* xb = (bf16*)(ws + WS_XB); float* ss0 = (float*)(ws + WS_SS);
      static_assert((M / 2048) % 2 == 0, "two rows per step");
      for (int m = gw; m < M; m += 2 * NGW) {
          const int m2 = m + NGW;
          const f32x4* xr = (const f32x4*)(x + (size_t)m * DM) + lane; const f32x4* xr2 = (const f32x4*)(x + (size_t)m2 * DM) + lane; f32x4 v[4], w[4]; float s = 0.f, s2 = 0.f;
#pragma unroll
          for (int j = 0; j < 4; ++j) { v[j] = xr[64 * j]; w[j] = xr2[64 * j]; }
#pragma unroll
          for (int j = 0; j < 4; ++j) { s += (v[j][0] * v[j][0] + v[j][1] * v[j][1]) + (v[j][2] * v[j][2] + v[j][3] * v[j][3]); s2 += (w[j][0] * w[j][0] + w[j][1] * w[j][1]) + (w[j][2] * w[j][2] + w[j][3] * w[j][3]); }
          s = wave_sum(s); s2 = wave_sum(s2);
          v2u* o8 = (v2u*)(xb + (size_t)m * DM) + lane; v2u* o82 = (v2u*)(xb + (size_t)m2 * DM) + lane;
#pragma unroll
          for (int j = 0; j < 4; ++j) { v2u p; p.x = pk2(v[j][0], v[j][1]); p.y = pk2(v[j][2], v[j][3]); o8[64 * j] = p; v2u p2; p2.x = pk2(w[j][0], w[j][1]); p2.y = pk2(w[j][2], w[j][3]); o82[64 * j] = p2; }
          if (lane < 16) { ss0[(size_t)m * 16 + lane] = lane == 0 ? s : 0.f; ss0[(size_t)m2 * 16 + lane] = lane == 0 ? s2 : 0.f; }
      } }
}

#define XB_TMO      128
#define XB_XCNT(j)  (256  + 64 * (j))
#define XB_XSUB(j)  (1280 + 64 * (j))
#define XB_XGEN(j)  (2304 + 64 * (j))
#define XB_TOP      3328
#define XB_TOPGEN   3392
#define XCD_BAR_WORDS 3456
#define XB_SPIN_CAP (1u << 18)

__device__ __forceinline__ unsigned xb_ld(unsigned* p)              { return __hip_atomic_load(p, __ATOMIC_RELAXED, __HIP_MEMORY_SCOPE_AGENT); }
__device__ __forceinline__ unsigned xb_add(unsigned* p, unsigned v) { return __hip_atomic_fetch_add(p, v, __ATOMIC_RELAXED, __HIP_MEMORY_SCOPE_AGENT); }
__device__ __forceinline__ unsigned xb_xcc_id() { return (unsigned)__builtin_amdgcn_s_getreg((3 << 11) | 20) & 0xFu; }
#define XB_SPIN(cond, bar) do { unsigned _sp = 0; while (cond) { __builtin_amdgcn_s_sleep(1); \
    if ((++_sp & 255u) == 0u) { if (xb_ld(&(bar)[XB_TMO])) break; if (_sp > XB_SPIN_CAP) { atomicAdd(&(bar)[XB_TMO], 1u); break; } } } } while (0)

struct XcdBarrier {
    unsigned* bar; unsigned x;
    volatile LAS unsigned* st;
};

__device__ __forceinline__ XcdBarrier xcd_barrier_post(unsigned* bar, volatile LAS unsigned* st) {
    XcdBarrier b; b.bar = bar; b.x = xb_xcc_id(); b.st = st;
    if (threadIdx.x == 0) (void)xb_add(&bar[XB_XCNT(b.x)], 1u);
    return b;
}
__device__ __forceinline__ void xcd_barrier_complete(unsigned* bar, unsigned x, unsigned& nloc, unsigned& nx) {
    const unsigned G = gridDim.x * gridDim.y * gridDim.z;
    unsigned sum, cnt, mine, sp = 0u;
    for (;;) {
        sum = 0u; cnt = 0u; mine = 0u;
#pragma unroll
        for (unsigned j = 0; j < 16; ++j) { const unsigned c = xb_ld(&bar[XB_XCNT(j)]); sum += c; cnt += (c > 0u) ? 1u : 0u; mine = (j == x) ? c : mine; }
        if (sum == G) break;
        __builtin_amdgcn_s_sleep(1);
        if ((++sp & 255u) == 0u) { if (xb_ld(&bar[XB_TMO])) break; if (sp > XB_SPIN_CAP) { atomicAdd(&bar[XB_TMO], 1u); break; } }
    }
    nloc = mine > 0u ? mine : 1u; nx = cnt > 0u ? cnt : 1u;
}

__device__ __forceinline__ void xcd_barrier(const XcdBarrier& b) {
    asm volatile("s_waitcnt vmcnt(0)" ::: "memory");
    __syncthreads();
    if (threadIdx.x == 0) {
        unsigned* bar = b.bar;
        __builtin_amdgcn_s_waitcnt(0);
        unsigned nloc = b.st[0], nx = b.st[1];
        if (nloc == 0u) { xcd_barrier_complete(bar, b.x, nloc, nx); b.st[0] = nloc; b.st[1] = nx; }
        const unsigned old = xb_add(&bar[XB_XSUB(b.x)], 1u);
        const unsigned gen = old / nloc;
        if (old + 1u == (gen + 1u) * nloc) {
            __builtin_amdgcn_fence(__ATOMIC_RELEASE, "agent");
            asm volatile("s_waitcnt vmcnt(0)" ::: "memory");
            const unsigned og = xb_add(&bar[XB_TOP], 1u);
            const unsigned tg = og / nx;
            if (og + 1u == (tg + 1u) * nx) xb_add(&bar[XB_TOPGEN], 1u);
            else XB_SPIN(xb_ld(&bar[XB_TOPGEN]) == tg, bar);
            __builtin_amdgcn_fence(__ATOMIC_ACQUIRE, "agent");
            xb_add(&bar[XB_XGEN(b.x)], 1u);
            asm volatile("s_waitcnt vmcnt(0)" ::: "memory");
        } else {
            XB_SPIN(xb_ld(&bar[XB_XGEN(b.x)]) == gen, bar);
            __builtin_amdgcn_fence(__ATOMIC_ACQUIRE, "agent");
            asm volatile("s_waitcnt vmcnt(0)" ::: "memory");
        }
    }
    __syncthreads();
}

__device__ __forceinline__ void grid_bar(unsigned* cnt, unsigned target) {
    asm volatile("s_waitcnt vmcnt(0)" ::: "memory");
    __syncthreads();
    if (threadIdx.x == 0) {
        __builtin_amdgcn_fence(__ATOMIC_RELEASE, "agent");
        asm volatile("s_waitcnt vmcnt(0)" ::: "memory");
        __hip_atomic_fetch_add(cnt, 1u, __ATOMIC_RELAXED, __HIP_MEMORY_SCOPE_AGENT);
        unsigned sp = 0;
        while (__hip_atomic_load(cnt, __ATOMIC_RELAXED, __HIP_MEMORY_SCOPE_AGENT) < target) { __builtin_amdgcn_s_sleep(2); if (++sp > (1u << 22)) break; }
        __builtin_amdgcn_fence(__ATOMIC_ACQUIRE, "agent");
        asm volatile("s_waitcnt vmcnt(0)" ::: "memory");
    }
    __syncthreads();
}

#define MFMA32(a, b, c) __builtin_amdgcn_mfma_f32_32x32x16_bf16((a), (b), (c), 0, 0, 0)
constexpr int KV_PITCH = 144;
constexpr int KV_TILE = 64 * KV_PITCH;
constexpr int ATT_NSLOT = 6;
constexpr int ATT_K0 = 0, ATT_V0 = ATT_NSLOT * KV_TILE, ATT_TAB = 2 * ATT_NSLOT * KV_TILE;
__device__ __forceinline__ s16x4 tr_read(unsigned lds_addr) { s16x4 r; asm volatile("ds_read_b64_tr_b16 %0, %1\n\ts_waitcnt lgkmcnt(0)" : "=&v"(r) : "v"(lds_addr) : "memory"); return r; }

__device__ __forceinline__ void attn_tile(const LAS unsigned char* Kb, unsigned Vaddr, const LAS float* tb, const bf16x8 (&qf)[4], unsigned krd, float& mrun, float& lrun, f32x16& o0, f32x16& o1) {
    f32x16 p0, p1;
#pragma unroll
    for (int r = 0; r < 16; ++r) { const int o = (r & 3) + 8 * (r >> 2); p0[r] = tb[o]; p1[r] = tb[o + 32]; }
#pragma unroll
    for (int ks = 0; ks < 4; ++ks) {
        const bf16x8 k0 = *(const LAS bf16x8*)(Kb + krd + ks * 32), k1 = *(const LAS bf16x8*)(Kb + krd + 32 * KV_PITCH + ks * 32);
        p0 = MFMA32(k0, qf[ks], p0); p1 = MFMA32(k1, qf[ks], p1);
    }
    s16x4 vt[16];
    asm volatile(
        "ds_read_b64_tr_b16 %0, %16 offset:0\n\tds_read_b64_tr_b16 %1, %16 offset:1152\n\tds_read_b64_tr_b16 %2, %16 offset:64\n\tds_read_b64_tr_b16 %3, %16 offset:1216\n\t"
        "ds_read_b64_tr_b16 %4, %16 offset:2304\n\tds_read_b64_tr_b16 %5, %16 offset:3456\n\tds_read_b64_tr_b16 %6, %16 offset:2368\n\tds_read_b64_tr_b16 %7, %16 offset:3520\n\t"
        "ds_read_b64_tr_b16 %8, %16 offset:4608\n\tds_read_b64_tr_b16 %9, %16 offset:5760\n\tds_read_b64_tr_b16 %10, %16 offset:4672\n\tds_read_b64_tr_b16 %11, %16 offset:5824\n\t"
        "ds_read_b64_tr_b16 %12, %16 offset:6912\n\tds_read_b64_tr_b16 %13, %16 offset:8064\n\tds_read_b64_tr_b16 %14, %16 offset:6976\n\tds_read_b64_tr_b16 %15, %16 offset:8128\n\t"
        "s_waitcnt lgkmcnt(0)"
        : "=&v"(vt[0]), "=&v"(vt[1]), "=&v"(vt[2]), "=&v"(vt[3]), "=&v"(vt[4]), "=&v"(vt[5]), "=&v"(vt[6]), "=&v"(vt[7]),
          "=&v"(vt[8]), "=&v"(vt[9]), "=&v"(vt[10]), "=&v"(vt[11]), "=&v"(vt[12]), "=&v"(vt[13]), "=&v"(vt[14]), "=&v"(vt[15])
        : "v"(Vaddr) : "memory");
    float rm = p0[0];
#pragma unroll
    for (int r = 1; r < 16; ++r) rm = fmaxf(rm, p0[r]);
#pragma unroll
    for (int r = 0; r < 16; ++r) rm = fmaxf(rm, p1[r]);
    rm = fmaxf(rm, __shfl_xor(rm, 32));
    if (__builtin_amdgcn_ballot_w64(rm > mrun + 8.0f) != 0ull) {
        const float mnew = fmaxf(mrun, rm), sc = __builtin_amdgcn_exp2f(mrun - mnew); mrun = mnew; lrun *= sc;
#pragma unroll
        for (int r = 0; r < 16; ++r) { o0[r] *= sc; o1[r] *= sc; }
    }
    float ls = 0.f;
#pragma unroll
    for (int r = 0; r < 16; ++r) { p0[r] = __builtin_amdgcn_exp2f(p0[r] - mrun); p1[r] = __builtin_amdgcn_exp2f(p1[r] - mrun); ls += p0[r] + p1[r]; }
    lrun += ls;
#pragma unroll
    for (int s = 0; s < 4; ++s) {
        v4u pw;
        if (s < 2) { pw.x = pg8::cvt_pk_bf16(p0[8 * s + 0], p0[8 * s + 1]); pw.y = pg8::cvt_pk_bf16(p0[8 * s + 2], p0[8 * s + 3]); pw.z = pg8::cvt_pk_bf16(p0[8 * s + 4], p0[8 * s + 5]); pw.w = pg8::cvt_pk_bf16(p0[8 * s + 6], p0[8 * s + 7]); }
        else { const int s2 = s - 2; pw.x = pg8::cvt_pk_bf16(p1[8 * s2 + 0], p1[8 * s2 + 1]); pw.y = pg8::cvt_pk_bf16(p1[8 * s2 + 2], p1[8 * s2 + 3]); pw.z = pg8::cvt_pk_bf16(p1[8 * s2 + 4], p1[8 * s2 + 5]); pw.w = pg8::cvt_pk_bf16(p1[8 * s2 + 6], p1[8 * s2 + 7]); }
        const bf16x8 pf = __builtin_bit_cast(bf16x8, pw);
        const bf16x8 v0 = __builtin_shufflevector(vt[4 * s + 0], vt[4 * s + 1], 0, 1, 2, 3, 4, 5, 6, 7), v1 = __builtin_shufflevector(vt[4 * s + 2], vt[4 * s + 3], 0, 1, 2, 3, 4, 5, 6, 7);
        o0 = MFMA32(v0, pf, o0); o1 = MFMA32(v1, pf, o1);
    }
}

__device__ __forceinline__ void attn_unit(int b, int h, int c0, const bf16* QKV, bf16* YATT, const float* relb, LAS unsigned char* lds, int tid, int wave, int lane) {
    const int l31 = lane & 31, hi = lane >> 5;
    const size_t tok0 = (size_t)b * SEQ;
    const int T0 = c0 - 8;
    const int srow = tid >> 3, sch = tid & 7;
    const bf16* kg = QKV + (tok0 + srow) * 1536 + 512 + h * 64 + sch * 8 + (long)T0 * 64 * 1536;
    const bf16* vg = kg + 512;
    const unsigned soff = srow * KV_PITCH + sch * 16;
#define ATT_LOAD(KR, VR, rel) do { const long c_ = (T0 + (rel)) < 0 ? -(long)T0 : (long)(rel); KR = *(const v4u*)(kg + c_ * 64 * 1536); VR = *(const v4u*)(vg + c_ * 64 * 1536); } while (0)
#define ATT_WRITE(KR, VR, rel) do { const int sl_ = (rel) % ATT_NSLOT; *(LAS v4u*)(lds + ATT_K0 + sl_ * KV_TILE + soff) = KR; *(LAS v4u*)(lds + ATT_V0 + sl_ * KV_TILE + soff) = VR; } while (0)
    v4u kA, vA, kB, vB, k0r, v0r, k1r, v1r, k2r, v2r, k3r, v3r;
    ATT_LOAD(k0r, v0r, 0); ATT_LOAD(k1r, v1r, 1); ATT_LOAD(k2r, v2r, 2); ATT_LOAD(k3r, v3r, 3); ATT_LOAD(kA, vA, 4); ATT_LOAD(kB, vB, 5);
    LAS float* tab = (LAS float*)(lds + ATT_TAB);
    const int jw = wave >> 1;
    const int cc = c0 + jw;
    const int ql = 32 * (wave & 1) + l31;
    bf16x8 qf[4];
    { const bf16* qp = QKV + (tok0 + (size_t)cc * 64 + ql) * 1536 + h * 64 + hi * 8;
#pragma unroll
      for (int ks = 0; ks < 4; ++ks) qf[ks] = *(const bf16x8*)(qp + ks * 16); }
    float tbv[3];
#pragma unroll
    for (int k = 0; k < 3; ++k) { const int i = tid + k * NTHREADS; const int ic = i < 9 * 128 ? i : 0; const int dd = ic >> 7, t = ic & 127; int d = 64 * dd + 63 - t; d = d > 256 ? 256 : d; tbv[k] = relb[h * 513 + d + 256] * pg8::LOG2E; }
#pragma unroll
    for (int k = 0; k < 3; ++k) { const int i = tid + k * NTHREADS; if (i < 9 * 128) tab[i] = tbv[k]; }
    ATT_WRITE(k0r, v0r, 0); ATT_WRITE(k1r, v1r, 1); ATT_WRITE(k2r, v2r, 2); ATT_WRITE(k3r, v3r, 3);
    asm volatile("" : "+v"(qf[0]), "+v"(qf[1]), "+v"(qf[2]), "+v"(qf[3]));
    __syncthreads();
    float mrun = -1e30f, lrun = 0.f;
    f32x16 o0, o1;
#pragma unroll
    for (int r = 0; r < 16; ++r) { o0[r] = 0.f; o1[r] = 0.f; }
    const unsigned ldsb = (unsigned)(size_t)lds;
    const int i16 = lane & 15, tq = i16 >> 2, tp = i16 & 3, blk = (lane >> 4) & 1;
    const unsigned vrd = (4 * hi + tq) * KV_PITCH + 8 * (4 * blk + tp);
    const unsigned krd = l31 * KV_PITCH + 16 * hi;
    const int tbase = 63 - ql + 4 * hi;
#define ATT_STEP(s_, KR, VR) do { \
        const int rel_ = (s_) + jw; \
        if (T0 + rel_ >= 0) { const int sl_ = rel_ % ATT_NSLOT; \
            attn_tile(lds + ATT_K0 + sl_ * KV_TILE, ldsb + ATT_V0 + sl_ * KV_TILE + vrd, tab + (8 - (s_)) * 128 + tbase, qf, krd, mrun, lrun, o0, o1); } \
        if ((s_) + 4 <= 11) ATT_WRITE(KR, VR, (s_) + 4); \
        if ((s_) + 6 <= 11) ATT_LOAD(KR, VR, (s_) + 6); \
        asm volatile("s_waitcnt lgkmcnt(0)\n\ts_barrier" ::: "memory"); } while (0)
    ATT_STEP(0, kA, vA); ATT_STEP(1, kB, vB); ATT_STEP(2, kA, vA); ATT_STEP(3, kB, vB); ATT_STEP(4, kA, vA); ATT_STEP(5, kB, vB); ATT_STEP(6, kA, vA); ATT_STEP(7, kB, vB); ATT_STEP(8, kA, vA);
#undef ATT_STEP
#undef ATT_LOAD
#undef ATT_WRITE
    const float lt = lrun + __shfl_xor(lrun, 32); const float inv = __builtin_amdgcn_rcpf(lt);
    bf16* op = YATT + (tok0 + (size_t)cc * 64 + ql) * 1024 + h * 64 + 4 * hi;
#pragma unroll
    for (int g = 0; g < 4; ++g) {
        v2u w0, w1;
        w0.x = pg8::cvt_pk_bf16(o0[4 * g] * inv, o0[4 * g + 1] * inv); w0.y = pg8::cvt_pk_bf16(o0[4 * g + 2] * inv, o0[4 * g + 3] * inv);
        w1.x = pg8::cvt_pk_bf16(o1[4 * g] * inv, o1[4 * g + 1] * inv); w1.y = pg8::cvt_pk_bf16(o1[4 * g + 2] * inv, o1[4 * g + 3] * inv);
        *(v2u*)(op + 8 * g) = w0; *(v2u*)(op + 32 + 8 * g) = w1;
    }
}

__device__ __forceinline__ void sgu_unit(int b, int n, const bf16* UV, bf16* YSGU, const bf16* WS, const float* lng, const float* lnb, const float* bs, LAS unsigned char* lds, int wave, int lane) {
    const size_t tok0 = (size_t)b * SEQ + (size_t)n * 128;
    {
        float gg[8], bb[8];
#pragma unroll
        for (int i = 0; i < 8; ++i) { gg[i] = lng[8 * lane + i]; bb[i] = lnb[8 * lane + i]; }
        const int g = lane >> 3, d0 = 8 * (lane & 7);
        const bf16* vsp = UV + (tok0 + 16 * wave) * 1024 + 512 + 8 * lane;
        v4u rawA = *(const v4u*)vsp, rawB = *(const v4u*)(vsp + 1024);
#pragma unroll
        for (int rr = 0; rr < 16; rr += 2) {
            const int j = 16 * wave + rr;
            const v4u ra = rawA, rb = rawB;
            { const int nx = rr + 2 < 16 ? rr + 2 : rr; rawA = *(const v4u*)(vsp + (size_t)nx * 1024); rawB = *(const v4u*)(vsp + (size_t)(nx + 1) * 1024); }
            float xa[8], xb[8];
            xa[0] = pg8::bf_lo(ra.x); xa[1] = pg8::bf_hi(ra.x); xa[2] = pg8::bf_lo(ra.y); xa[3] = pg8::bf_hi(ra.y); xa[4] = pg8::bf_lo(ra.z); xa[5] = pg8::bf_hi(ra.z); xa[6] = pg8::bf_lo(ra.w); xa[7] = pg8::bf_hi(ra.w);
            xb[0] = pg8::bf_lo(rb.x); xb[1] = pg8::bf_hi(rb.x); xb[2] = pg8::bf_lo(rb.y); xb[3] = pg8::bf_hi(rb.y); xb[4] = pg8::bf_lo(rb.z); xb[5] = pg8::bf_hi(rb.z); xb[6] = pg8::bf_lo(rb.w); xb[7] = pg8::bf_hi(rb.w);
            float sa = 0.f, qa = 0.f, sb = 0.f, qb = 0.f;
#pragma unroll
            for (int i = 0; i < 8; ++i) { sa += xa[i]; qa += xa[i] * xa[i]; sb += xb[i]; qb += xb[i] * xb[i]; }
#pragma unroll
            for (int o = 1; o < 64; o <<= 1) { sa += __shfl_xor(sa, o); qa += __shfl_xor(qa, o); sb += __shfl_xor(sb, o); qb += __shfl_xor(qb, o); }
            const float mua = sa * (1.0f / 512.0f), mub = sb * (1.0f / 512.0f);
            const float ra_ = __builtin_amdgcn_rsqf(fmaxf(qa * (1.0f / 512.0f) - mua * mua, 0.f) + 1e-6f), rb_ = __builtin_amdgcn_rsqf(fmaxf(qb * (1.0f / 512.0f) - mub * mub, 0.f) + 1e-6f);
            v4u oa, ob;
            oa.x = pg8::cvt_pk_bf16((xa[0] - mua) * ra_ * gg[0] + bb[0], (xa[1] - mua) * ra_ * gg[1] + bb[1]); oa.y = pg8::cvt_pk_bf16((xa[2] - mua) * ra_ * gg[2] + bb[2], (xa[3] - mua) * ra_ * gg[3] + bb[3]);
            oa.z = pg8::cvt_pk_bf16((xa[4] - mua) * ra_ * gg[4] + bb[4], (xa[5] - mua) * ra_ * gg[5] + bb[5]); oa.w = pg8::cvt_pk_bf16((xa[6] - mua) * ra_ * gg[6] + bb[6], (xa[7] - mua) * ra_ * gg[7] + bb[7]);
            ob.x = pg8::cvt_pk_bf16((xb[0] - mub) * rb_ * gg[0] + bb[0], (xb[1] - mub) * rb_ * gg[1] + bb[1]); ob.y = pg8::cvt_pk_bf16((xb[2] - mub) * rb_ * gg[2] + bb[2], (xb[3] - mub) * rb_ * gg[3] + bb[3]);
            ob.z = pg8::cvt_pk_bf16((xb[4] - mub) * rb_ * gg[4] + bb[4], (xb[5] - mub) * rb_ * gg[5] + bb[5]); ob.w = pg8::cvt_pk_bf16((xb[6] - mub) * rb_ * gg[6] + bb[6], (xb[7] - mub) * rb_ * gg[7] + bb[7]);
            *(LAS v4u*)(lds + g * 16384 + j * 128 + d0 * 2) = oa; *(LAS v4u*)(lds + g * 16384 + (j + 1) * 128 + d0 * 2) = ob;
        }
    }
    __syncthreads();
    {
        const int g = wave, l31 = lane & 31, hi = lane >> 5;
        const int i16 = lane & 15, tq = i16 >> 2, tp = i16 & 3, blk = (lane >> 4) & 1;
        const unsigned img = (unsigned)(size_t)lds + g * 16384 + (8 * hi + tq) * 128 + 8 * (4 * blk + tp);
        const bf16* wg = WS + (size_t)g * 128 * 128;
#pragma unroll
        for (int it = 0; it < 4; ++it) {
            f32x16 c0, c1;
#pragma unroll
            for (int r = 0; r < 16; ++r) { c0[r] = 0.f; c1[r] = 0.f; }
            const int ns = it < 2 ? 4 : 8;
            const bf16* wp = wg + (size_t)(32 * it + l31) * 128 + 8 * hi;
            bf16x8 wfn = *(const bf16x8*)wp;
            const bf16* up = UV + (tok0 + 32 * it + l31) * 1024 + g * 64 + 4 * hi;
            v2u uu0[4], uu1[4];
#pragma unroll
            for (int q = 0; q < 4; ++q) { uu0[q] = *(const v2u*)(up + 8 * q); uu1[q] = *(const v2u*)(up + 32 + 8 * q); }
#pragma unroll
            for (int s = 0; s < 8; ++s) { if (s >= ns) break;
                const bf16x8 wf = wfn; wfn = *(const bf16x8*)(wp + 16 * (s + 1 < ns ? s + 1 : s));
                const unsigned va = img + (16 * s) * 128;
                s16x4 a0, a1, b0, b1;
                asm volatile("ds_read_b64_tr_b16 %0, %4 offset:0\n\tds_read_b64_tr_b16 %1, %4 offset:512\n\tds_read_b64_tr_b16 %2, %4 offset:64\n\tds_read_b64_tr_b16 %3, %4 offset:576\n\ts_waitcnt lgkmcnt(0)"
                             : "=&v"(a0), "=&v"(a1), "=&v"(b0), "=&v"(b1) : "v"(va) : "memory");
                const bf16x8 v0 = __builtin_shufflevector(a0, a1, 0, 1, 2, 3, 4, 5, 6, 7), v1 = __builtin_shufflevector(b0, b1, 0, 1, 2, 3, 4, 5, 6, 7);
                c0 = MFMA32(v0, wf, c0); c1 = MFMA32(v1, wf, c1);
            }
            const int i = 32 * it + l31; const float bsi = bs[g * 128 + i];
            bf16* yp = YSGU + (tok0 + i) * 1024 + 512 + g * 64 + 4 * hi;
#pragma unroll
            for (int q = 0; q < 4; ++q) {
                const v2u u0 = uu0[q], u1 = uu1[q];
                v2u w0, w1;
                w0.x = pg8::cvt_pk_bf16(pg8::bf_lo(u0.x) * (c0[4 * q] + bsi), pg8::bf_hi(u0.x) * (c0[4 * q + 1] + bsi)); w0.y = pg8::cvt_pk_bf16(pg8::bf_lo(u0.y) * (c0[4 * q + 2] + bsi), pg8::bf_hi(u0.y) * (c0[4 * q + 3] + bsi));
                w1.x = pg8::cvt_pk_bf16(pg8::bf_lo(u1.x) * (c1[4 * q] + bsi), pg8::bf_hi(u1.x) * (c1[4 * q + 1] + bsi)); w1.y = pg8::cvt_pk_bf16(pg8::bf_lo(u1.y) * (c1[4 * q + 2] + bsi), pg8::bf_hi(u1.y) * (c1[4 * q + 3] + bsi));
                *(v2u*)(yp + 8 * q) = w0; *(v2u*)(yp + 32 + 8 * q) = w1;
            }
        }
    }
    __syncthreads();
}

constexpr int N_PHASES = 10;
__global__ void __launch_bounds__(NTHREADS, 2) mega_fwd(Args args) {
    extern __shared__ __attribute__((aligned(16))) unsigned char lds_raw[];
    LAS unsigned char* lds = (LAS unsigned char*)lds_raw;
    const int tid = threadIdx.x, lane = tid & 63, wave = __builtin_amdgcn_readfirstlane(tid >> 6);
    const int G = gridDim.x, bx = blockIdx.x;
    const int vcu = (G % 8 == 0) ? (bx % 8) * (G / 8) + bx / 8 : bx;
    const int gw = vcu * NWAVES + wave, NGW = G * NWAVES;
    unsigned char* ws = args.ws;
    const int lo = args.ph_lo, hi = args.ph_hi;
    float* ss0 = (float*)(ws + WS_SS); float* ss1 = ss0 + (size_t)M * 16; float* ss2 = ss1 + (size_t)M * 16; float* ss3 = ss2 + (size_t)M * 16;
    bf16* XB = (bf16*)(ws + WS_XB); bf16* A1 = (bf16*)(ws + WS_A1);
    bf16* QKV = (bf16*)(ws + WS_QKV); bf16* UV = (bf16*)(ws + WS_UV); bf16* GATES = (bf16*)(ws + WS_GATES);
    bf16* YATT = (bf16*)(ws + WS_YATT); bf16* YSGU = (bf16*)(ws + WS_YATT); bf16* MG = (bf16*)(ws + WS_MG);
#define IN(k) (lo <= (k) && (k) < hi)
    unsigned* barcnt = (unsigned*)(ws + WS_BAR);
    unsigned bar_target = 0;
    volatile LAS unsigned* xst = (volatile LAS unsigned*)(lds + LDS_BYTES - 16);
    if (tid == 0) { xst[0] = 0u; xst[1] = 0u; }
    __syncthreads();
    XcdBarrier xbar; xbar.bar = (unsigned*)(ws + WS_XBAR); xbar.x = 0; xbar.st = xst;
#define SEAM(k) do { if (IN(k) && IN((k) + 1)) { if (lo != 0 || hi != N_PHASES) { cg::this_grid().sync(); } \
        else if (USE_XCD_BAR) xcd_barrier(xbar); else { bar_target += (unsigned)G; grid_bar(barcnt, bar_target); } } } while (0)

    if (lo == 0 && hi == N_PHASES) {
        if (bx == 0 && tid == 0) __hip_atomic_store((unsigned*)(ws + WS_BAR), 0u, __ATOMIC_RELAXED, __HIP_MEMORY_SCOPE_AGENT);
        if (bx == 0 && tid < 128) __hip_atomic_store((unsigned*)(ws + WS_PCNT) + 64 * tid, 0u, __ATOMIC_RELAXED, __HIP_MEMORY_SCOPE_AGENT);
        if (bx == 0) for (int i = tid; i < XCD_BAR_WORDS; i += NTHREADS) __hip_atomic_store((unsigned*)(ws + WS_XBAR) + i, 0u, __ATOMIC_RELAXED, __HIP_MEMORY_SCOPE_AGENT);
        cg::this_grid().sync();
        xbar = xcd_barrier_post((unsigned*)(ws + WS_XBAR), xst);
    }
    if (IN(0)) { p0_prologue(args, lds, gw, NGW, wave, lane); }
    SEAM(0);
    if (IN(1)) {
        pg8::Gemm g{XB, (const bf16*)(ws + WS_WGU1), M, 2 * DFF, DM}; pg8::StaticOrder S; S.init(M, 2 * DFF, G, bx, WGM_WIDE);
        pg8::EpiSwiglu E{A1, DFF, ss0};
        pg8::gemm_phase<pg8::EpiSwiglu, pg8::StaticOrder, true, true>(lds, g, S, E);
    }
    SEAM(1);
    if (IN(2)) {
        pg8::Gemm g{A1, (const bf16*)(ws + WS_WD1), M, DM, DFF}; pg8::StaticOrder S; S.init(M, DM, G, bx);
        pg8::EpiResid E{args.in[0], args.out, XB, ss1, 0.5f, 2.0f};
        pg8::gemm_phase<pg8::EpiResid, pg8::StaticOrder, true, true>(lds, g, S, E);
    }
    SEAM(2);
    if (IN(3)) {
        pg8::Gemm g{XB, (const bf16*)(ws + WS_WIN), M, DIN, DM}; pg8::StaticOrder S; S.init(M, DIN, G, bx, WGM_WIDE);
        pg8::EpiWin E{QKV, UV, GATES, args.in[7], ss1};
        pg8::gemm_phase<pg8::EpiWin, pg8::StaticOrder, true, true>(lds, g, S, E);
    }
    SEAM(3);
    if (IN(4)) {
        for (int u = vcu; u < BATCH * 8 * (NCHUNK / 4); u += G) {
            const int c4 = u % (NCHUNK / 4), bh = u / (NCHUNK / 4), h = bh % 8, b = bh / 8;
            attn_unit(b, h, 4 * c4, QKV, YATT, args.in[8], lds, tid, wave, lane);
        }
        for (int u = vcu; u < BATCH * (SEQ / 128); u += G) {
            sgu_unit(u / (SEQ / 128), u % (SEQ / 128), UV, YSGU, (const bf16*)(ws + WS_WSGU), args.in[9], args.in[10], args.in[12], lds, wave, lane);
        }
    }
    SEAM(4);
    if (IN(5)) {
        pg8::Gemm g{YATT, (const bf16*)(ws + WS_WBA), M, DM, DM}; pg8::StaticOrder S; S.init(M, DM, G, bx);
        pg8::EpiBranchCat E{MG, GATES, 8};
        pg8::gemm_phase<pg8::EpiBranchCat, pg8::StaticOrder, true, true>(lds, g, S, E);
    }
    SEAM(5);
    if (IN(6)) {
        pg8::Gemm g{MG, (const bf16*)(ws + WS_WOUT), M, DM, DM}; pg8::StaticOrder S; S.init(M, DM, G, bx);
        pg8::EpiResid E{args.out, args.out, XB, ss2, 1.0f, 1.0f};
        pg8::gemm_phase<pg8::EpiResid, pg8::StaticOrder, true, true>(lds, g, S, E);
    }
    SEAM(6);
    if (IN(7)) {
        pg8::Gemm g{XB, (const bf16*)(ws + WS_WGU2), M, 2 * DFF, DM}; pg8::StaticOrder S; S.init(M, 2 * DFF, G, bx, WGM_WIDE);
        pg8::EpiSwiglu E{A1, DFF, ss2};
        pg8::gemm_phase<pg8::EpiSwiglu, pg8::StaticOrder, true, true>(lds, g, S, E);
    }
    SEAM(7);
    if (IN(8)) {
        pg8::Gemm g{A1, (const bf16*)(ws + WS_WD2), M, DM, DFF}; pg8::StaticOrder S; S.init(M, DM, G, bx);
        pg8::EpiResidNorm E{args.out, args.out, ss3, (unsigned*)(ws + WS_PCNT), args.in[20], 0.5f, 2.0f};
        pg8::gemm_phase<pg8::EpiResidNorm, pg8::StaticOrder, true, true>(lds, g, S, E);
    }
    if (!FUSE_FINAL) SEAM(8);
    if (!FUSE_FINAL && IN(9)) {
        const float* gf = args.in[20]; f32x4 gv[4];
#pragma unroll
        for (int j = 0; j < 4; ++j) gv[j] = *((const f32x4*)gf + lane + 64 * j);
        for (int m = gw; m < M; m += NGW) {
            const float rs = pg8::row_rstd(ss3, m);
            f32x4* xr = (f32x4*)(args.out + (size_t)m * DM) + lane;
#pragma unroll
            for (int j = 0; j < 4; ++j) { f32x4 v = xr[64 * j]; v = v * rs * gv[j]; xr[64 * j] = v; }
        }
    }
#undef IN
#undef SEAM
}

#ifndef MK_MULTI
#define MK_MULTI 0
#endif
extern "C" void kernel_launch(void* const* d_in, const int* in_sizes, int n_in, void* d_out, int out_size, void* d_ws, size_t ws_size, hipStream_t stream) {
    static int grid = 0;
    if (grid == 0) {
        if (n_in != 21 || in_sizes[0] != M * DM || out_size != M * DM || ws_size < WS_END) { fprintf(stderr, "kernel_launch: unexpected shapes (n_in %d, in0 %d, out %d, ws %zu < %zu)\n", n_in, n_in > 0 ? in_sizes[0] : -1, out_size, ws_size, (size_t)WS_END); grid = -1; return; }
        int dev = 0, cus = 0, per_cu = 0;
        if (hipGetDevice(&dev) != hipSuccess || hipDeviceGetAttribute(&cus, hipDeviceAttributeMultiprocessorCount, dev) != hipSuccess) { grid = -1; return; }
        if (hipFuncSetAttribute((const void*)mega_fwd, hipFuncAttributeMaxDynamicSharedMemorySize, LDS_BYTES) != hipSuccess) { fprintf(stderr, "kernel_launch: hipFuncSetAttribute failed\n"); grid = -1; return; }
        if (hipOccupancyMaxActiveBlocksPerMultiprocessor(&per_cu, (const void*)mega_fwd, NTHREADS, LDS_BYTES) != hipSuccess || per_cu < 1) { fprintf(stderr, "kernel_launch: occupancy query says %d\n", per_cu); (void)hipGetLastError(); per_cu = 1; }
        grid = cus * 1;
    }
    if (grid < 0) return;
    Args a{};
    for (int i = 0; i < 21; ++i) a.in[i] = (const float*)d_in[i];
    a.out = (float*)d_out; a.ws = (unsigned char*)d_ws;
#if MK_MULTI
    for (int p = 0; p < N_PHASES; ++p) { a.ph_lo = p; a.ph_hi = p + 1; hipLaunchKernelGGL(mega_fwd, dim3(grid), dim3(NTHREADS), LDS_BYTES, stream, a); }
#else
    a.ph_lo = 0; a.ph_hi = N_PHASES;
    void* kargs[] = {&a};
    hipError_t e = hipLaunchCooperativeKernel((const void*)mega_fwd, dim3(grid), dim3(NTHREADS), kargs, LDS_BYTES, stream);
    if (e != hipSuccess) fprintf(stderr, "cooperative launch failed: %s (grid %d)\n", hipGetErrorString(e), grid);
#endif
}
```
